# Optimizing an MI355X kernel written in HIP

```python
import jax, jax.numpy as jnp
from jax import lax
import numpy as np

D_MODEL = 1024
BATCH = 2
SEQ = 8192
DEPTH = 1

N_ATTN_HEADS = 8
ATTN_HEAD_DIM = 64
ATTN_WIDTH = N_ATTN_HEADS * ATTN_HEAD_DIM
MOBA_BLOCK = 256
MOBA_TOPK = 3
Q_BLOCK = 128
GMLP_GROUPS = 8
GMLP_GROUP_DIM = 64
GMLP_WIDTH = GMLP_GROUPS * GMLP_GROUP_DIM
GMLP_CHUNK = 128
IN_SPLITS = (ATTN_WIDTH, 2 * ATTN_WIDTH, 3 * ATTN_WIDTH,
             3 * ATTN_WIDTH + GMLP_WIDTH, 3 * ATTN_WIDTH + 2 * GMLP_WIDTH,
             3 * ATTN_WIDTH + 2 * GMLP_WIDTH + D_MODEL)
IN_COLS = 3 * ATTN_WIDTH + 2 * GMLP_WIDTH + 2 * D_MODEL
PEER_HEADS = 8
PEER_N_KEYS = 128
PEER_N_EXPERTS = PEER_N_KEYS * PEER_N_KEYS
PEER_QUERY_DIM = 256
PEER_HALF = PEER_QUERY_DIM // 2
PEER_TOPK = 16
PEER_TOKEN_BLOCK = 128
ALPHA = float((2.0 * DEPTH) ** 0.25)
BETA = float((8.0 * DEPTH) ** -0.25)
LN_EPS = 1e-5

kernel_name = 'moba_gmlp_peer_deepnorm_adaln_block'


def _layernorm(x):
    xf = x.astype(jnp.float32)
    mu = xf.mean(-1, keepdims=True)
    var = jnp.square(xf - mu).mean(-1, keepdims=True)
    return ((xf - mu) * lax.rsqrt(var + LN_EPS)).astype(x.dtype)


def _alibi_slopes(n):
    return jnp.asarray([2.0 ** (-8.0 * (i + 1) / n) for i in range(n)], jnp.float32)


def _moba_attention(q, k, v):
    B, S, H, Dh = q.shape
    nb = -(-S // MOBA_BLOCK)
    pad = nb * MOBA_BLOCK - S
    kp = jnp.pad(k, ((0, 0), (0, pad), (0, 0), (0, 0)))
    vp = jnp.pad(v, ((0, 0), (0, pad), (0, 0), (0, 0)))
    kb = kp.reshape(B, nb, MOBA_BLOCK, H, Dh).transpose(0, 3, 1, 2, 4)
    vb = vp.reshape(B, nb, MOBA_BLOCK, H, Dh).transpose(0, 3, 1, 2, 4)
    kmean = kb.astype(jnp.float32).mean(axis=3)
    k_sel = min(MOBA_TOPK, nb)
    nq = S // Q_BLOCK
    qc = q.reshape(B, nq, Q_BLOCK, H, Dh).transpose(1, 0, 3, 2, 4)
    slopes = _alibi_slopes(H)
    scale = Dh ** -0.5
    gather_bh = jax.vmap(jax.vmap(lambda tab, idx: tab[idx]))

    def one_block(args):
        q_blk, ci = args
        t = ci * Q_BLOCK + jnp.arange(Q_BLOCK)
        own = (ci * Q_BLOCK) // MOBA_BLOCK
        gate = jnp.einsum('bhqd,bhnd->bhqn', q_blk.astype(jnp.float32), kmean)
        gate = jnp.where(jnp.arange(nb) < own, gate, -jnp.inf)
        _, sel = lax.top_k(gate, k_sel)
        sel_ok = sel < own
        k_g = gather_bh(kb, sel)
        v_g = gather_bh(vb, sel)
        s_sel = jnp.einsum('bhqd,bhqkld->bhqkl', q_blk, k_g).astype(jnp.float32) * scale
        pos_sel = sel[..., None] * MOBA_BLOCK + jnp.arange(MOBA_BLOCK)
        dist_sel = jnp.abs(t[None, None, :, None, None] - pos_sel).astype(jnp.float32)
        s_sel = s_sel - slopes[None, :, None, None, None] * dist_sel
        s_sel = jnp.where(sel_ok[..., None], s_sel, -jnp.inf)
        k_own = lax.dynamic_index_in_dim(kb, own, axis=2, keepdims=False)
        v_own = lax.dynamic_index_in_dim(vb, own, axis=2, keepdims=False)
        s_own = jnp.einsum('bhqd,bhld->bhql', q_blk, k_own).astype(jnp.float32) * scale
        diff = t[:, None] - (own * MOBA_BLOCK + jnp.arange(MOBA_BLOCK))[None, :]
        s_own = s_own - slopes[:, None, None] * jnp.abs(diff).astype(jnp.float32)
        s_own = jnp.where(diff >= 0, s_own, -jnp.inf)
        scores = jnp.concatenate([s_sel.reshape(B, H, Q_BLOCK, k_sel * MOBA_BLOCK), s_own], axis=-1)
        p = jax.nn.softmax(scores, axis=-1)
        p_sel = p[..., :k_sel * MOBA_BLOCK].reshape(B, H, Q_BLOCK, k_sel, MOBA_BLOCK).astype(v.dtype)
        p_own = p[..., k_sel * MOBA_BLOCK:].astype(v.dtype)
        return (jnp.einsum('bhqkl,bhqkld->bhqd', p_sel, v_g)
                + jnp.einsum('bhql,bhld->bhqd', p_own, v_own))

    out = lax.map(one_block, (qc, jnp.arange(nq)))
    return out.transpose(1, 0, 3, 2, 4).reshape(B, S, H * Dh)


def _chunked_sgu(gu, gv, sgu_ln_g, sgu_ln_b, w_spatial, b_spatial):
    B, S, _ = gu.shape
    u = jax.nn.gelu(gu, approximate=False)
    vv = jax.nn.gelu(gv, approximate=False).reshape(B, S, GMLP_GROUPS, GMLP_GROUP_DIM)
    vv = _layernorm(vv) * sgu_ln_g + sgu_ln_b
    nc = S // GMLP_CHUNK
    vv = vv.reshape(B, nc, GMLP_CHUNK, GMLP_GROUPS, GMLP_GROUP_DIM)
    mask = jnp.tril(jnp.ones((GMLP_CHUNK, GMLP_CHUNK), dtype=bool))
    w = jnp.where(mask, w_spatial, 0)
    sv = jnp.einsum('gts,bcsgd->bctgd', w, vv) + b_spatial.T[None, None, :, :, None]
    return u * sv.reshape(B, S, GMLP_WIDTH)


def _peer(h, w_peer_q, peer_sub_keys, peer_u, peer_v):
    B, S, D = h.shape
    q = (h @ w_peer_q).reshape(B, S, PEER_HEADS, 2, PEER_HALF)
    s = jnp.einsum('bshcd,hcnd->bshcn', q, peer_sub_keys).astype(jnp.float32)
    top_s, top_i = lax.top_k(s, PEER_TOPK)
    cand = (top_s[..., 0, :, None] + top_s[..., 1, None, :]).reshape(B, S, PEER_HEADS, PEER_TOPK * PEER_TOPK)
    cand_idx = (top_i[..., 0, :, None] * PEER_N_KEYS + top_i[..., 1, None, :]).reshape(B, S, PEER_HEADS, PEER_TOPK * PEER_TOPK)
    best_s, best_pos = lax.top_k(cand, PEER_TOPK)
    expert_idx = jnp.take_along_axis(cand_idx, best_pos, axis=-1)
    g = jax.nn.softmax(best_s, axis=-1).astype(h.dtype)
    nt = (B * S) // PEER_TOKEN_BLOCK
    e_per_tok = PEER_HEADS * PEER_TOPK
    hx = h.reshape(nt, PEER_TOKEN_BLOCK, D)
    ix = expert_idx.reshape(nt, PEER_TOKEN_BLOCK, e_per_tok)
    gx = g.reshape(nt, PEER_TOKEN_BLOCK, e_per_tok)

    def one(args):
        hb, ib, gb = args
        u = peer_u[ib]
        a = jax.nn.gelu(jnp.einsum('td,ted->te', hb, u), approximate=False)
        return jnp.einsum('te,ted->td', gb * a, peer_v[ib])

    return lax.map(one, (hx, ix, gx)).reshape(B, S, D)


def _modulate(x, shift, scale):
    return _layernorm(x) * (1 + scale[:, None, :]) + shift[:, None, :]


def setup_inputs(seed: int = 0) -> dict:
    key = jax.random.key(seed)
    ks = jax.random.split(key, 24)
    L, D = DEPTH, D_MODEL
    nrm = lambda k, shape, s: jax.random.normal(k, shape, jnp.float32) * s
    return {
        'x': nrm(ks[0], (BATCH, SEQ, D), 1.0),
        'c': nrm(ks[1], (BATCH, D), 1.0),
        'w_cond': nrm(ks[2], (L, D, 6 * D), 0.2 * D ** -0.5),
        'b_cond': nrm(ks[3], (L, 6 * D), 0.01),
        'w_in': nrm(ks[4], (L, D, IN_COLS), D ** -0.5),
        'w_attn_up': nrm(ks[5], (L, ATTN_WIDTH, D), ATTN_WIDTH ** -0.5),
        'w_gmlp_up': nrm(ks[6], (L, GMLP_WIDTH, D), GMLP_WIDTH ** -0.5),
        'w_out': nrm(ks[7], (L, D, D), BETA * D ** -0.5),
        'sgu_ln_g': 1.0 + nrm(ks[8], (L, GMLP_GROUPS, GMLP_GROUP_DIM), 0.02),
        'sgu_ln_b': nrm(ks[9], (L, GMLP_GROUPS, GMLP_GROUP_DIM), 0.02),
        'w_spatial': nrm(ks[10], (L, GMLP_GROUPS, GMLP_CHUNK, GMLP_CHUNK), 0.5 * GMLP_CHUNK ** -0.5),
        'b_spatial': 1.0 + nrm(ks[11], (L, GMLP_GROUPS, GMLP_CHUNK), 0.02),
        'ln1_g': 1.0 + nrm(ks[12], (L, D), 0.02),
        'ln1_b': nrm(ks[13], (L, D), 0.02),
        'w_peer_q': nrm(ks[14], (L, D, PEER_HEADS * PEER_QUERY_DIM), D ** -0.5),
        'peer_sub_keys': nrm(ks[15], (L, PEER_HEADS, 2, PEER_N_KEYS, PEER_HALF), PEER_HALF ** -0.5),
        'peer_u': nrm(ks[16], (L, PEER_N_EXPERTS, D), D ** -0.5),
        'peer_v': nrm(ks[17], (L, PEER_N_EXPERTS, D), BETA),
        'ln2_g': 1.0 + nrm(ks[18], (L, D), 0.02),
        'ln2_b': nrm(ks[19], (L, D), 0.02),
    }


def reference(x, c, w_cond, b_cond, w_in, w_attn_up, w_gmlp_up, w_out, sgu_ln_g, sgu_ln_b,
              w_spatial, b_spatial, ln1_g, ln1_b, w_peer_q, peer_sub_keys, peer_u, peer_v,
              ln2_g, ln2_b):
    B, S, D = x.shape
    cs = jax.nn.silu(c)
    for l in range(DEPTH):
        mod = cs @ w_cond[l] + b_cond[l]
        sh1, sc1, gt1, sh2, sc2, gt2 = jnp.split(mod, 6, axis=-1)
        h = _modulate(x, sh1, sc1)
        z = h @ w_in[l]
        q, k, v, gu, gv, ga, gg = jnp.split(z, IN_SPLITS, axis=-1)
        hs = (B, S, N_ATTN_HEADS, ATTN_HEAD_DIM)
        attn = _moba_attention(q.reshape(hs), k.reshape(hs), v.reshape(hs))
        sgu = _chunked_sgu(gu, gv, sgu_ln_g[l], sgu_ln_b[l], w_spatial[l], b_spatial[l])
        merged = (jax.nn.sigmoid(ga) * (attn @ w_attn_up[l])
                  + jax.nn.sigmoid(gg) * (sgu @ w_gmlp_up[l]))
        out = merged @ w_out[l]
        x = _layernorm(ALPHA * x + (1 + gt1[:, None, :]) * out) * ln1_g[l] + ln1_b[l]
        h = _modulate(x, sh2, sc2)
        p = _peer(h, w_peer_q[l], peer_sub_keys[l], peer_u[l], peer_v[l])
        x = _layernorm(ALPHA * x + (1 + gt2[:, None, :]) * p) * ln2_g[l] + ln2_b[l]
    return x
```

```cpp
#include <hip/hip_runtime.h>
#include <cstdio>
#include <cstdint>
#include <cmath>
namespace pg8 {
#define PG8_LAS __attribute__((address_space(3)))
typedef unsigned short bf16_t;
typedef short bf16x8 __attribute__((ext_vector_type(8)));
typedef float f32x4 __attribute__((ext_vector_type(4)));
typedef unsigned u32x4 __attribute__((ext_vector_type(4)));
constexpr int BM = 256, BK = 64, HALF = 128, HTB = HALF * BK * 2  , STAGE_BYTES = 8 * HTB, NXCD = 8, WGM = 8;

__host__ __device__ __forceinline__ int lds_byte(int r, int c) { const int st = (r >> 4) * 2 + (c >> 5), rr = r & 15, cc = c & 31, ob = rr * 64 + cc * 2; return st * 1024 + (ob ^ (((ob >> 9) & 1) << 5)); }
__host__ __device__ __forceinline__ void stage_rc(int b, int& R, int& C) { const int st = b / 1024, sb = b % 1024, swz = sb ^ (((sb >> 9) & 1) << 5); R = (st >> 1) * 16 + swz / 64; C = (st & 1) * 32 + (swz % 64) / 2; }
__host__ __device__ __forceinline__ int perm32(int rho) { const int n = rho >> 4, i = rho & 15; return 8 * (i >> 2) + 4 * n + (i & 3); }

struct Unit { int pm, pn; };
struct Gemm { const bf16_t* A; const bf16_t* Bt; int M, N, K, lda, ldb; };

struct StaticOrder {
    int nM, nN, nwg, G, c;
    __host__ __device__ void init(int M, int N, int G_, int c_) { nM = M / BM; nN = N / BM; nwg = nM * nN; G = G_; c = c_; }
    __host__ __device__ bool next(int i, Unit& u) const {
        const long L = (long)i * G + c; if (L >= nwg) return false;
        int wgid = (int)L; { const int q = nwg / NXCD, r = nwg % NXCD, xcd = wgid % NXCD, off = wgid / NXCD; wgid = (xcd < r ? xcd * (q + 1) : r * (q + 1) + (xcd - r) * q) + off; }
        const int nig = WGM * nN, gid = wgid / nig, fm = gid * WGM, gsz = (nM - fm) < WGM ? (nM - fm) : WGM;
        u.pm = fm + ((wgid % nig) % gsz); u.pn = (wgid % nig) / gsz; return true;
    }
    __device__ __forceinline__ void a_ready(const Unit&) const {}
    __device__ __forceinline__ void done(const Unit&) const {}
};

__device__ __forceinline__ unsigned cvt_pk_bf16(float lo, float hi) { unsigned r; asm volatile("v_cvt_pk_bf16_f32 %0, %1, %2" : "=v"(r) : "v"(lo), "v"(hi)); return r; }
typedef float f32x2 __attribute__((ext_vector_type(2)));
__device__ __forceinline__ f32x2 gelu_pk(f32x2 v) {
    const f32x2 av = __builtin_elementwise_abs(v), d = av * 0.2316418882f + 1.0f;
    f32x2 t; t.x = __builtin_amdgcn_rcpf(d.x); t.y = __builtin_amdgcn_rcpf(d.y);
    f32x2 q = t * 0.5307027145f + (-0.7265760135f); q = q * t + 0.7107068705f; q = q * t + (-0.142248368f); q = q * t + 0.127414796f; q = q * t;
    const f32x2 s = (v * v) * (-0.72134752044f);
    f32x2 e; e.x = __builtin_amdgcn_exp2f(s.x); e.y = __builtin_amdgcn_exp2f(s.y);
    const f32x2 m = v * (q * e), r = v - m;
    f32x2 o; o.x = v.x < 0.f ? m.x : r.x; o.y = v.y < 0.f ? m.y : r.y; return o;
}

template <class Fn> struct EpiFn {
    static constexpr bool PERM = true, AFTER_DRAIN = false; Fn fn;
    __device__ __forceinline__ void operator()(const f32x4 (&acc)[2][2][4][2], const Unit& u, int wr, int wc, int fr, int fq) const {
        const int row0 = u.pm * BM + wr * 64 + fr, col0 = u.pn * BM + wc * 32 + 8 * fq;
#pragma unroll
        for (int ai = 0; ai < 2; ++ai)
#pragma unroll
            for (int m = 0; m < 4; ++m)
#pragma unroll
                for (int bj = 0; bj < 2; ++bj) fn(row0 + ai * HALF + m * 16, col0 + bj * HALF, acc[ai][bj][m][0], acc[ai][bj][m][1], u.pn);
    }
};
__device__ __forceinline__ u32x4 pack8(f32x4 v0, f32x4 v1) { u32x4 w; w.x = cvt_pk_bf16(v0[0], v0[1]); w.y = cvt_pk_bf16(v0[2], v0[3]); w.z = cvt_pk_bf16(v1[0], v1[1]); w.w = cvt_pk_bf16(v1[2], v1[3]); return w; }
__device__ __forceinline__ f32x4 gelu4(f32x4 v) { f32x2 a = gelu_pk((f32x2){v[0], v[1]}), b = gelu_pk((f32x2){v[2], v[3]}); return (f32x4){a.x, a.y, b.x, b.y}; }
__device__ __forceinline__ float sigm1(float x) { return __builtin_amdgcn_rcpf(1.0f + __builtin_amdgcn_exp2f(-1.4426950408889634f * x)); }
__device__ __forceinline__ f32x4 sigm4(f32x4 v) { return (f32x4){sigm1(v[0]), sigm1(v[1]), sigm1(v[2]), sigm1(v[3])}; }
__device__ __forceinline__ void unpack8(u32x4 w, f32x4& a, f32x4& b) {
    a = (f32x4){__uint_as_float(w.x << 16), __uint_as_float(w.x & 0xffff0000u), __uint_as_float(w.y << 16), __uint_as_float(w.y & 0xffff0000u)};
    b = (f32x4){__uint_as_float(w.z << 16), __uint_as_float(w.z & 0xffff0000u), __uint_as_float(w.w << 16), __uint_as_float(w.w & 0xffff0000u)};
}
template <class Epi, class Sched, bool ALIGN_EPI = false, bool SP2 = false>
__device__ __forceinline__ void gemm_phase(PG8_LAS unsigned char* lds, const Gemm g, const Sched& S, const Epi& E) {
    const int tid = threadIdx.x, wid = __builtin_amdgcn_readfirstlane(tid >> 6), lane = tid & 63, wr = wid >> 2, wc = wid & 3, fr = lane & 15, fq = lane >> 4;
    const int K = g.K, nt = K / BK;
    unsigned voffA[2], voffB[2];
#pragma unroll
    for (int i = 0; i < 2; ++i) { int R, C; stage_rc(tid * 16 + i * 8192, R, C); const int Rb = Epi::PERM ? ((R & ~31) + perm32(R & 31)) : R;
        voffA[i] = (unsigned)(R * g.lda + C) * 2u; voffB[i] = (unsigned)(Rb * g.ldb + C) * 2u; }
    const size_t kstep = (size_t)(BK * 2);
    const size_t hstepA = (size_t)HALF * g.lda * 2, hstepB = (size_t)HALF * g.ldb * 2;
    const size_t tstepA = 2 * hstepA, tstepB = 2 * hstepB;
    const unsigned ldsw = (unsigned)wid * 1024u;
    const int aoff = lds_byte(wr * 64 + fr, fq * 8), boff = lds_byte(wc * 32 + fr, fq * 8);
#define PG8_SA(b, h) (((b) * 2 + (h)) * HTB)
#define PG8_SB(b, h) ((4 + (b) * 2 + (h)) * HTB)
#define PG8_STAGE(bufoff, gbase, voff) do { _Pragma("unroll") for (int _i = 0; _i < 2; ++_i) \
        __builtin_amdgcn_global_load_lds((const unsigned*)((const char*)(gbase) + (voff)[_i]), (PG8_LAS unsigned*)(lds + (bufoff) + ldsw + _i * 8192), 16, 0, 0); } while (0)
#define PG8_LDA(dst, b, h) do { _Pragma("unroll") for (int m = 0; m < 4; ++m) _Pragma("unroll") for (int k = 0; k < 2; ++k) dst[m][k] = *(const PG8_LAS bf16x8*)(lds + PG8_SA(b, h) + aoff + m * 2048 + k * 1024); } while (0)
#define PG8_LDB(dst, b, h) do { _Pragma("unroll") for (int n = 0; n < 2; ++n) _Pragma("unroll") for (int k = 0; k < 2; ++k) dst[n][k] = *(const PG8_LAS bf16x8*)(lds + PG8_SB(b, h) + boff + n * 2048 + k * 1024); } while (0)
#define PG8_MMA(ai, bj, At, Bt) do { __builtin_amdgcn_s_setprio(1); _Pragma("unroll") for (int m = 0; m < 4; ++m) _Pragma("unroll") for (int n = 0; n < 2; ++n) _Pragma("unroll") for (int k = 0; k < 2; ++k) \
        acc[ai][bj][m][n] = __builtin_amdgcn_mfma_f32_16x16x32_bf16(Bt[n][k], At[m][k], acc[ai][bj][m][n], 0, 0, 0); __builtin_amdgcn_s_setprio(0); } while (0)
#define PG8_WAIT_V(n) asm volatile("s_waitcnt vmcnt(" #n ")" ::: "memory")
#define PG8_WAIT_L(n) asm volatile("s_waitcnt lgkmcnt(" #n ")" ::: "memory")
#define PG8_BAR __builtin_amdgcn_s_barrier()
#define PG8_SCHED __builtin_amdgcn_sched_barrier(0)
    Unit cur, nxt; int ui = 0;
    if (!S.next(0, cur)) return;
    f32x4 acc[2][2][4][2];
#pragma unroll
    for (int a = 0; a < 2; ++a)
#pragma unroll
        for (int b = 0; b < 2; ++b)
#pragma unroll
            for (int m = 0; m < 4; ++m)
#pragma unroll
                for (int n = 0; n < 2; ++n) acc[a][b][m][n] = (f32x4){0.f, 0.f, 0.f, 0.f};
    bf16x8 At[4][2], B0[2][2], B1[2][2];
    const char* cA = (const char*)g.A + (size_t)cur.pm * tstepA; const char* cB = (const char*)g.Bt + (size_t)cur.pn * tstepB;
    S.a_ready(cur);
    if constexpr (SP2) {
        PG8_STAGE(PG8_SB(0, 0), cB, voffB); PG8_STAGE(PG8_SB(0, 1), cB + hstepB, voffB); PG8_STAGE(PG8_SA(0, 0), cA, voffA); PG8_STAGE(PG8_SA(0, 1), cA + hstepA, voffA);
        if (wr == 1) PG8_BAR;
        PG8_WAIT_V(2); PG8_BAR;
        PG8_STAGE(PG8_SB(1, 0), cB + kstep, voffB); PG8_STAGE(PG8_SA(1, 0), cA + kstep, voffA); PG8_STAGE(PG8_SB(1, 1), cB + hstepB + kstep, voffB);
        PG8_WAIT_V(6); PG8_BAR;
    } else {
        PG8_STAGE(PG8_SB(0, 0), cB, voffB); PG8_STAGE(PG8_SA(0, 0), cA, voffA); PG8_STAGE(PG8_SB(0, 1), cB + hstepB, voffB); PG8_STAGE(PG8_SA(0, 1), cA + hstepA, voffA);
        if (wr == 1) PG8_BAR;
        PG8_WAIT_V(4); PG8_BAR;
        PG8_STAGE(PG8_SB(1, 0), cB + kstep, voffB); PG8_STAGE(PG8_SA(1, 0), cA + kstep, voffA); PG8_STAGE(PG8_SB(1, 1), cB + hstepB + kstep, voffB);
        PG8_WAIT_V(6); PG8_BAR;
    }
    for (;;) {
        const bool has_next = S.next(ui + 1, nxt);
        const char* nA = has_next ? (const char*)g.A + (size_t)nxt.pm * tstepA : cA; const char* nB = has_next ? (const char*)g.Bt + (size_t)nxt.pn * tstepB : cB;
        for (int t = 0; t < nt; t += 2) {
            const bool last = (t == nt - 2);
            const char* a1 = cA + (size_t)(t + 1) * kstep;
            const char* a2 = last ? nA : cA + (size_t)(t + 2) * kstep; const char* b2 = last ? nB : cB + (size_t)(t + 2) * kstep;
            const char* a3 = a2 + kstep; const char* b3 = b2 + kstep;
            if (last && has_next) S.a_ready(nxt);
            if constexpr (SP2) {
            PG8_LDB(B0, 0, 0); PG8_LDB(B1, 0, 1); PG8_SCHED; PG8_LDA(At, 0, 0); PG8_STAGE(PG8_SA(1, 1), a1 + hstepA, voffA);
            PG8_WAIT_V(8); PG8_WAIT_L(0); PG8_BAR; PG8_MMA(0, 0, At, B0); PG8_MMA(0, 1, At, B1); PG8_BAR; PG8_SCHED;
            PG8_LDA(At, 0, 1); PG8_STAGE(PG8_SB(0, 0), b2, voffB); PG8_STAGE(PG8_SB(0, 1), b2 + hstepB, voffB); PG8_STAGE(PG8_SA(0, 0), a2, voffA);
            PG8_WAIT_V(8); PG8_WAIT_L(0); PG8_BAR; PG8_MMA(1, 0, At, B0); PG8_MMA(1, 1, At, B1); PG8_BAR; PG8_SCHED;
            PG8_LDB(B0, 1, 0); PG8_LDB(B1, 1, 1); PG8_SCHED; PG8_LDA(At, 1, 0); PG8_STAGE(PG8_SA(0, 1), a2 + hstepA, voffA);
            PG8_WAIT_V(8); PG8_WAIT_L(0); PG8_BAR; PG8_MMA(0, 0, At, B0); PG8_MMA(0, 1, At, B1); PG8_BAR; PG8_SCHED;
            PG8_LDA(At, 1, 1); PG8_STAGE(PG8_SB(1, 0), b3, voffB); PG8_STAGE(PG8_SB(1, 1), b3 + hstepB, voffB); PG8_STAGE(PG8_SA(1, 0), a3, voffA);
            PG8_WAIT_V(8); PG8_WAIT_L(0); PG8_BAR; PG8_MMA(1, 0, At, B0); PG8_MMA(1, 1, At, B1); PG8_BAR; PG8_SCHED;
            } else {
            PG8_LDB(B0, 0, 0); PG8_SCHED; PG8_LDA(At, 0, 0); PG8_STAGE(PG8_SA(1, 1), a1 + hstepA, voffA);
            PG8_WAIT_L(8); PG8_BAR; PG8_WAIT_L(0); PG8_MMA(0, 0, At, B0); PG8_BAR; PG8_SCHED;
            PG8_LDB(B1, 0, 1); PG8_STAGE(PG8_SB(0, 0), b2, voffB);
            PG8_BAR; PG8_WAIT_L(0); PG8_MMA(0, 1, At, B1); PG8_BAR;
            PG8_LDA(At, 0, 1); PG8_STAGE(PG8_SA(0, 0), a2, voffA);
            PG8_BAR; PG8_WAIT_L(0); PG8_MMA(1, 0, At, B0); PG8_BAR; PG8_SCHED;
            PG8_STAGE(PG8_SB(0, 1), b2 + hstepB, voffB);
            PG8_WAIT_V(6); PG8_BAR; PG8_MMA(1, 1, At, B1); PG8_BAR;
            PG8_LDB(B0, 1, 0); PG8_SCHED; PG8_LDA(At, 1, 0); PG8_STAGE(PG8_SA(0, 1), a2 + hstepA, voffA);
            PG8_WAIT_L(8); PG8_BAR; PG8_WAIT_L(0); PG8_MMA(0, 0, At, B0); PG8_BAR; PG8_SCHED;
            PG8_LDB(B1, 1, 1); PG8_STAGE(PG8_SB(1, 0), b3, voffB);
            PG8_BAR; PG8_WAIT_L(0); PG8_MMA(0, 1, At, B1); PG8_BAR;
            PG8_LDA(At, 1, 1); PG8_STAGE(PG8_SA(1, 0), a3, voffA);
            PG8_BAR; PG8_WAIT_L(0); PG8_MMA(1, 0, At, B0); PG8_BAR; PG8_SCHED;
            PG8_STAGE(PG8_SB(1, 1), b3 + hstepB, voffB);
            PG8_WAIT_V(6); PG8_BAR; PG8_MMA(1, 1, At, B1); PG8_BAR;
            }
        }
        if constexpr (ALIGN_EPI) { if (wr == 0) PG8_BAR; }
        if constexpr (!Epi::AFTER_DRAIN) { E(acc, cur, wr, wc, fr, fq); S.done(cur); }
        if (!has_next) break;
#pragma unroll
        for (int a = 0; a < 2; ++a)
#pragma unroll
            for (int b = 0; b < 2; ++b)
#pragma unroll
                for (int m = 0; m < 4; ++m)
#pragma unroll
                    for (int n = 0; n < 2; ++n) acc[a][b][m][n] = (f32x4){0.f, 0.f, 0.f, 0.f};
        cur = nxt; cA = nA; cB = nB; ++ui;
        if constexpr (ALIGN_EPI) { if (wr == 1) PG8_BAR; }
    }
    PG8_WAIT_V(0);
    if constexpr (!ALIGN_EPI) { if (wr == 0) PG8_BAR; }
    PG8_BAR;
    if constexpr (Epi::AFTER_DRAIN) { E.fused(acc, cur, wr, wc, fr, fq, lds, wid, lane); S.done(cur); }
#undef PG8_SA
#undef PG8_SB
#undef PG8_STAGE
#undef PG8_LDA
#undef PG8_LDB
#undef PG8_MMA
#undef PG8_WAIT_V
#undef PG8_WAIT_L
#undef PG8_BAR
#undef PG8_SCHED
}
}
#define GAS __attribute__((address_space(1)))
#define LAS __attribute__((address_space(3)))
typedef unsigned short bf16;
typedef unsigned v4u __attribute__((ext_vector_type(4)));
typedef float f32x4 __attribute__((ext_vector_type(4)));
typedef short bf16x8 __attribute__((ext_vector_type(8)));
typedef GAS unsigned gu32;
typedef GAS unsigned long long gu64;
#define RLX_AGENT __ATOMIC_RELAXED, __HIP_MEMORY_SCOPE_AGENT
#define LDS_WAIT() asm volatile("s_waitcnt lgkmcnt(0)" ::: "memory")
#define VM_WAIT() asm volatile("s_waitcnt vmcnt(0)" ::: "memory")
__device__ __forceinline__ unsigned long long rt() { return __builtin_amdgcn_s_memrealtime(); }
__device__ __forceinline__ unsigned f2bf(float f) { unsigned u = __builtin_bit_cast(unsigned, f); return (u + 0x7fffu + ((u >> 16) & 1u)) >> 16; }
__device__ __forceinline__ unsigned pk2(float lo, float hi) { return f2bf(lo) | (f2bf(hi) << 16); }

#define XB_TMO      128
#define XB_XCNT(j)  (256  + 64 * (j))
#define XB_XSUB(j)  (1280 + 64 * (j))
#define XB_XGEN(j)  (2304 + 64 * (j))
#define XB_TOP      3328
#define XB_TOPGEN   3392
#define XCD_BAR_WORDS 3456
#define XB_SPIN_CAP (1u << 18)

__device__ __forceinline__ unsigned xb_ld(unsigned* p)              { return __hip_atomic_load(p, __ATOMIC_RELAXED, __HIP_MEMORY_SCOPE_AGENT); }
__device__ __forceinline__ unsigned xb_add(unsigned* p, unsigned v) { return __hip_atomic_fetch_add(p, v, __ATOMIC_RELAXED, __HIP_MEMORY_SCOPE_AGENT); }
__device__ __forceinline__ unsigned xb_xcc_id() { return (unsigned)__builtin_amdgcn_s_getreg((3 << 11) | 20) & 0xFu; }
#define XB_SPIN(cond, bar) do { unsigned _sp = 0; while (cond) { __builtin_amdgcn_s_sleep(1); \
    if ((++_sp & 255u) == 0u) { if (xb_ld(&(bar)[XB_TMO])) break; if (_sp > XB_SPIN_CAP) { atomicAdd(&(bar)[XB_TMO], 1u); break; } } } } while (0)

struct XcdBarrier {
    unsigned* bar; unsigned x;
    volatile LAS unsigned* st;
};

__device__ __forceinline__ XcdBarrier xcd_barrier_post(unsigned* bar, volatile LAS unsigned* st) {
    XcdBarrier b; b.bar = bar; b.x = xb_xcc_id(); b.st = st;
    if (threadIdx.x == 0) (void)xb_add(&bar[XB_XCNT(b.x)], 1u);
    return b;
}
__device__ __forceinline__ void xcd_barrier_complete(unsigned* bar, unsigned x, unsigned& nloc, unsigned& nx) {
    const unsigned G = gridDim.x * gridDim.y * gridDim.z;
    unsigned sum, cnt, mine, sp = 0u;
    for (;;) {
        sum = 0u; cnt = 0u; mine = 0u;
#pragma unroll
        for (unsigned j = 0; j < 16; ++j) { const unsigned c = xb_ld(&bar[XB_XCNT(j)]); sum += c; cnt += (c > 0u) ? 1u : 0u; mine = (j == x) ? c : mine; }
        if (sum == G) break;
        __builtin_amdgcn_s_sleep(1);
        if ((++sp & 255u) == 0u) { if (xb_ld(&bar[XB_TMO])) break; if (sp > XB_SPIN_CAP) { atomicAdd(&bar[XB_TMO], 1u); break; } }
    }
    nloc = mine > 0u ? mine : 1u; nx = cnt > 0u ? cnt : 1u;
}

__device__ __forceinline__ void xcd_barrier(const XcdBarrier& b) {
    asm volatile("s_waitcnt vmcnt(0)" ::: "memory");
    __syncthreads();
    if (threadIdx.x == 0) {
        unsigned* bar = b.bar;
        __builtin_amdgcn_s_waitcnt(0);
        unsigned nloc = b.st[0], nx = b.st[1];
        if (nloc == 0u) { xcd_barrier_complete(bar, b.x, nloc, nx); b.st[0] = nloc; b.st[1] = nx; }
        const unsigned old = xb_add(&bar[XB_XSUB(b.x)], 1u);
        const unsigned gen = old / nloc;
        if (old + 1u == (gen + 1u) * nloc) {
            __builtin_amdgcn_fence(__ATOMIC_RELEASE, "agent");
            asm volatile("s_waitcnt vmcnt(0)" ::: "memory");
            const unsigned og = xb_add(&bar[XB_TOP], 1u);
            const unsigned tg = og / nx;
            if (og + 1u == (tg + 1u) * nx) xb_add(&bar[XB_TOPGEN], 1u);
            else XB_SPIN(xb_ld(&bar[XB_TOPGEN]) == tg, bar);
            __builtin_amdgcn_fence(__ATOMIC_ACQUIRE, "agent");
            xb_add(&bar[XB_XGEN(b.x)], 1u);
            asm volatile("s_waitcnt vmcnt(0)" ::: "memory");
        } else {
            XB_SPIN(xb_ld(&bar[XB_XGEN(b.x)]) == gen, bar);
            __builtin_amdgcn_fence(__ATOMIC_ACQUIRE, "agent");
            asm volatile("s_waitcnt vmcnt(0)" ::: "memory");
        }
    }
    __syncthreads();
}

constexpr int NWAVES = 8;
constexpr int NB = 2, SEQ = 8192, D = 1024, M = NB * SEQ;
constexpr int NH = 8, HD = 64;
constexpr int MOBA_BLK = 256, NBLK = SEQ / MOBA_BLK;
constexpr int INC = 4608;
constexpr int ZC = 2560;
constexpr int ZQ = 0, ZK = 512, ZV = 1024, ZGU = 1536, ZGV = 2048;
constexpr int GC = 2048;
constexpr int PQC = 2048;
constexpr int NEXP = 16384;
constexpr float LN_EPS = 1e-5f;
constexpr float ALPHA = 1.189207115002721f;
constexpr float LOG2E = 1.4426950408889634f;
constexpr float C2 = 0.125f * LOG2E;

constexpr size_t MiB = 1u << 20;
constexpr size_t WS_CTL = 0, CTL_ZERO_BYTES = 1 * MiB;
constexpr size_t WS_MOD = 1 * MiB;
constexpr size_t WS_KMEAN = 1 * MiB + 64 * 1024;
constexpr size_t WS_WIN = 2 * MiB;
constexpr size_t WS_WA = 11 * MiB, WS_WG = 12 * MiB;
constexpr size_t WS_WOUT = 13 * MiB;
constexpr size_t WS_WPQ = 15 * MiB;
constexpr size_t WS_U16 = 20 * MiB, WS_V16 = 52 * MiB;
constexpr size_t WS_XN = 84 * MiB;
constexpr size_t WS_ZC = 116 * MiB;
constexpr size_t WS_TS = 180 * MiB;
constexpr size_t WS_IDX = 196 * MiB, WS_GW = 204 * MiB;
constexpr size_t WS_END = 212 * MiB;
constexpr int CW_BAR = 4096;

constexpr int RING_BYTES = 131072;
constexpr int LDSCTL_OFF = RING_BYTES, MISC_OFF = LDSCTL_OFF + 320;
constexpr int LDS_BYTES = 147456;

struct Frame {
    LAS unsigned char* lds;
    volatile LAS unsigned* MISC;
    gu32* ctl;
    int tid, lane, wave, G;
    const float *x, *c, *w_cond, *b_cond, *w_in, *w_attn_up, *w_gmlp_up, *w_out, *sgu_ln_g, *sgu_ln_b, *w_spatial, *b_spatial, *ln1_g, *ln1_b, *w_peer_q, *sub_keys, *peer_u, *peer_v, *ln2_g, *ln2_b;
    float* out;
    float *mod, *kmean, *ts, *gw; int* idx;
    bf16 *win_t, *wa_t, *wg_t, *wout_t, *wpq_t, *u16, *v16, *xn, *zc, *pq, *gates;
};

__device__ __forceinline__ float wave_sum(float v) {
#pragma unroll
    for (int o = 1; o < 64; o <<= 1) v += __shfl_xor(v, o);
    return v;
}
__device__ __forceinline__ float bflo(unsigned w) { return __uint_as_float(w << 16); }
__device__ __forceinline__ float bfhi(unsigned w) { return __uint_as_float(w & 0xffff0000u); }
__device__ __forceinline__ float silu1(float x) { return x / (1.0f + __expf(-x)); }
__device__ __forceinline__ float gelu_erf(float x) { return 0.5f * x * (1.0f + erff(x * 0.70710678118654752f)); }

__device__ __forceinline__ void p0_transpose_item(const float* W, int K, int N, bf16* WT, LAS float* scr, int item, int lane) {
    const int nblk = N / 32, kb = item / nblk, nb = item % nblk, k0 = 64 * kb, n0 = 32 * nb;
#pragma unroll 8
    for (int i = 0; i < 32; ++i) { const int kk = 2 * i + (lane >> 5); scr[kk * 33 + (lane & 31)] = W[(size_t)(k0 + kk) * N + n0 + (lane & 31)]; }
    LDS_WAIT(); asm volatile("" ::: "memory");
    const int c = lane & 7;
#pragma unroll
    for (int j = 0; j < 4; ++j) { const int n = (lane >> 3) + 8 * j; const LAS float* s = scr + (8 * c) * 33 + n;
        v4u o; o.x = pk2(s[0 * 33], s[1 * 33]); o.y = pk2(s[2 * 33], s[3 * 33]); o.z = pk2(s[4 * 33], s[5 * 33]); o.w = pk2(s[6 * 33], s[7 * 33]);
        *(GAS v4u*)(WT + (size_t)(n0 + n) * K + k0 + 8 * c) = o; }
    LDS_WAIT(); asm volatile("" ::: "memory");
}

__device__ __forceinline__ void p0_prologue(Frame& F) {
    {
        LAS float* part = (LAS float*)F.lds;
        for (int cg = blockIdx.x; cg < 256; cg += F.G) {
            if (F.tid < 384) {
                const int col = F.tid % 24, ks = F.tid / 24, j = 24 * cg + col;
                float a0 = 0.f, a1 = 0.f;
                for (int k = 64 * ks; k < 64 * ks + 64; ++k) {
                    const float wv = F.w_cond[(size_t)k * 6144 + j];
                    a0 += silu1(F.c[k]) * wv; a1 += silu1(F.c[1024 + k]) * wv;
                }
                part[(ks * 24 + col) * 2 + 0] = a0; part[(ks * 24 + col) * 2 + 1] = a1;
            }
            __syncthreads();
            if (F.tid < 48) {
                const int col = F.tid % 24, b = F.tid / 24; float s = F.b_cond[24 * cg + col];
                for (int ks = 0; ks < 16; ++ks) s += part[(ks * 24 + col) * 2 + b];
                F.mod[b * 6144 + 24 * cg + col] = s;
            }
            __syncthreads();
        }
    }
    {
        LAS float* scr = (LAS float*)(F.lds + F.wave * 16384);
        const int gw = blockIdx.x * NWAVES + F.wave, NGW = F.G * NWAVES;
        constexpr int I_IN = (D / 64) * (INC / 32), I_UP = (512 / 64) * (D / 32), I_OUT = (D / 64) * (D / 32), I_PQ = (D / 64) * (PQC / 32);
        constexpr int NITEMS = I_IN + 2 * I_UP + I_OUT + I_PQ;
        for (int it = gw; it < NITEMS; it += NGW) {
            int r = it;
            if (r < I_IN) { p0_transpose_item(F.w_in, D, INC, F.win_t, scr, r, F.lane); continue; } r -= I_IN;
            if (r < I_UP) { p0_transpose_item(F.w_attn_up, 512, D, F.wa_t, scr, r, F.lane); continue; } r -= I_UP;
            if (r < I_UP) { p0_transpose_item(F.w_gmlp_up, 512, D, F.wg_t, scr, r, F.lane); continue; } r -= I_UP;
            if (r < I_OUT) { p0_transpose_item(F.w_out, D, D, F.wout_t, scr, r, F.lane); continue; } r -= I_OUT;
            p0_transpose_item(F.w_peer_q, D, PQC, F.wpq_t, scr, r, F.lane);
        }
    }
    {
        const size_t n8 = (size_t)NEXP * D / 8;
        const size_t gt = (size_t)blockIdx.x * (NWAVES * 64) + F.tid, NT = (size_t)F.G * (NWAVES * 64);
        for (size_t i = gt; i < 2 * n8; i += NT) {
            const bool second = i >= n8; const size_t j = second ? i - n8 : i;
            const f32x4* s = (const f32x4*)((second ? F.peer_v : F.peer_u) + j * 8);
            const f32x4 a = s[0], b = s[1];
            v4u o; o.x = pk2(a.x, a.y); o.y = pk2(a.z, a.w); o.z = pk2(b.x, b.y); o.w = pk2(b.z, b.w);
            *(v4u*)((second ? F.v16 : F.u16) + j * 8) = o;
        }
    }
}

__device__ __forceinline__ void p1_modulate(Frame& F) {
    const int gw = blockIdx.x * NWAVES + F.wave, NGW = F.G * NWAVES;
    for (int m = gw; m < M; m += NGW) {
        const int b = m >> 13;
        const f32x4* xr = (const f32x4*)(F.x + (size_t)m * D) + F.lane;
        f32x4 v[4]; float s = 0.f;
#pragma unroll
        for (int j = 0; j < 4; ++j) { v[j] = xr[64 * j]; s += (v[j].x + v[j].y) + (v[j].z + v[j].w); }
        const float mean = wave_sum(s) * (1.f / D); float s2 = 0.f;
#pragma unroll
        for (int j = 0; j < 4; ++j) { v[j] = v[j] - mean; s2 += (v[j].x * v[j].x + v[j].y * v[j].y) + (v[j].z * v[j].z + v[j].w * v[j].w); }
        const float rstd = 1.f / sqrtf(wave_sum(s2) * (1.f / D) + LN_EPS);
        unsigned long long* o8 = (unsigned long long*)(F.xn + (size_t)m * D) + F.lane;
#pragma unroll
        for (int j = 0; j < 4; ++j) {
            const int col = 4 * F.lane + 256 * j;
            const f32x4 sh = *(const f32x4*)(F.mod + b * 6144 + col), sc = *(const f32x4*)(F.mod + b * 6144 + 1024 + col);
            const f32x4 y = v[j] * rstd * (sc + 1.0f) + sh;
            o8[64 * j] = (unsigned long long)pk2(y.x, y.y) | ((unsigned long long)pk2(y.z, y.w) << 32);
        }
    }
}

__device__ __forceinline__ void p3_kmean(Frame& F) {
    const int gt = blockIdx.x * (NWAVES * 64) + F.tid, NT = F.G * (NWAVES * 64);
    for (int i = gt; i < NB * NBLK * 512; i += NT) {
        const int col = i & 511, bb = i >> 9; const bf16* p = F.zc + (size_t)bb * 256 * ZC + ZK + col;
        float s = 0.f;
        for (int r = 0; r < 256; ++r) s += bflo((unsigned)p[(size_t)r * ZC]);
        F.kmean[i] = s * (1.0f / 256.0f);
    }
}

__device__ __forceinline__ void p3_sgu(Frame& F) {
    LAS float* vvn = (LAS float*)F.lds;
    LAS float* wsp = (LAS float*)(F.lds + 32768);
    const int t = F.tid >> 2, dq = F.tid & 3;
    for (int u = blockIdx.x; u < 1024; u += F.G) {
        const int chunk = u >> 3, g = u & 7; const size_t row0 = (size_t)chunk * 128;
        __syncthreads();
        {
            const bf16* p = F.zc + (row0 + t) * ZC + ZGV + g * 64 + dq * 16;
            const v4u w0 = *(const v4u*)p, w1 = *(const v4u*)(p + 8);
            float v[16];
            v[0] = bflo(w0.x); v[1] = bfhi(w0.x); v[2] = bflo(w0.y); v[3] = bfhi(w0.y); v[4] = bflo(w0.z); v[5] = bfhi(w0.z); v[6] = bflo(w0.w); v[7] = bfhi(w0.w);
            v[8] = bflo(w1.x); v[9] = bfhi(w1.x); v[10] = bflo(w1.y); v[11] = bfhi(w1.y); v[12] = bflo(w1.z); v[13] = bfhi(w1.z); v[14] = bflo(w1.w); v[15] = bfhi(w1.w);
            float s = 0.f;
#pragma unroll
            for (int k = 0; k < 16; ++k) s += v[k];
            s += __shfl_xor(s, 1); s += __shfl_xor(s, 2);
            const float mean = s * (1.0f / 64.0f); float q = 0.f;
#pragma unroll
            for (int k = 0; k < 16; ++k) { v[k] -= mean; q += v[k] * v[k]; }
            q += __shfl_xor(q, 1); q += __shfl_xor(q, 2);
            const float rstd = 1.f / sqrtf(q * (1.0f / 64.0f) + LN_EPS);
#pragma unroll
            for (int k = 0; k < 16; ++k) { const int d = dq * 16 + k; vvn[t * 64 + d] = v[k] * rstd * F.sgu_ln_g[g * 64 + d] + F.sgu_ln_b[g * 64 + d]; }
        }
        for (int i = F.tid; i < 16384; i += NWAVES * 64) wsp[(i >> 7) * 129 + (i & 127)] = F.w_spatial[(size_t)g * 16384 + i];
        __syncthreads();
        float acc[16];
#pragma unroll
        for (int k = 0; k < 16; ++k) acc[k] = 0.f;
        for (int s = 0; s <= t; ++s) {
            const float wv = wsp[t * 129 + s];
            const LAS f32x4* vp = (const LAS f32x4*)(vvn + s * 64 + dq * 16);
#pragma unroll
            for (int k4 = 0; k4 < 4; ++k4) { const f32x4 x = vp[k4]; acc[4 * k4 + 0] += wv * x.x; acc[4 * k4 + 1] += wv * x.y; acc[4 * k4 + 2] += wv * x.z; acc[4 * k4 + 3] += wv * x.w; }
        }
        const float bsp = F.b_spatial[g * 128 + t];
        bf16* up = F.zc + (row0 + t) * ZC + ZGU + g * 64 + dq * 16;
        const v4u u0 = *(const v4u*)up, u1 = *(const v4u*)(up + 8);
        v4u o0, o1;
        o0.x = pk2(bflo(u0.x) * (acc[0] + bsp), bfhi(u0.x) * (acc[1] + bsp)); o0.y = pk2(bflo(u0.y) * (acc[2] + bsp), bfhi(u0.y) * (acc[3] + bsp));
        o0.z = pk2(bflo(u0.z) * (acc[4] + bsp), bfhi(u0.z) * (acc[5] + bsp)); o0.w = pk2(bflo(u0.w) * (acc[6] + bsp), bfhi(u0.w) * (acc[7] + bsp));
        o1.x = pk2(bflo(u1.x) * (acc[8] + bsp), bfhi(u1.x) * (acc[9] + bsp)); o1.y = pk2(bflo(u1.y) * (acc[10] + bsp), bfhi(u1.y) * (acc[11] + bsp));
        o1.z = pk2(bflo(u1.z) * (acc[12] + bsp), bfhi(u1.z) * (acc[13] + bsp)); o1.w = pk2(bflo(u1.w) * (acc[14] + bsp), bfhi(u1.w) * (acc[15] + bsp));
        *(v4u*)up = o0; *(v4u*)(up + 8) = o1;
    }
    __syncthreads();
}

__device__ __forceinline__ void ld32bf(const bf16* p, float (&v)[32]) {
#pragma unroll
    for (int i = 0; i < 4; ++i) { const v4u w = *(const v4u*)(p + 8 * i);
        v[8 * i + 0] = bflo(w.x); v[8 * i + 1] = bfhi(w.x); v[8 * i + 2] = bflo(w.y); v[8 * i + 3] = bfhi(w.y);
        v[8 * i + 4] = bflo(w.z); v[8 * i + 5] = bfhi(w.z); v[8 * i + 6] = bflo(w.w); v[8 * i + 7] = bfhi(w.w); }
}
__device__ __forceinline__ void attn_simple_unit(Frame& F, int b, int h, int qb) {
    LAS float* Ks = (LAS float*)F.lds;
    LAS float* Vs = Ks + 256 * 64;
    const int ql = F.tid >> 1, half = F.tid & 1, t = qb * 256 + ql;
    const size_t rowq = (size_t)b * SEQ + t;
    bf16* qp = F.zc + rowq * ZC + ZQ + h * 64 + half * 32;
    float q[32]; ld32bf(qp, q);
    const float sl2 = exp2f(-(float)(h + 1)) * LOG2E;
    unsigned mask = 0u;
    {
        float g1 = -INFINITY, g2 = -INFINITY, g3 = -INFINITY; int i1 = -1, i2 = -1, i3 = -1;
        for (int j = 0; j < qb; ++j) {
            const float* km = F.kmean + ((size_t)(b * NBLK + j) * 512 + h * 64 + half * 32);
            float s = 0.f;
#pragma unroll
            for (int d = 0; d < 32; ++d) s += q[d] * km[d];
            s += __shfl_xor(s, 1);
            if (s > g1) { g3 = g2; i3 = i2; g2 = g1; i2 = i1; g1 = s; i1 = j; }
            else if (s > g2) { g3 = g2; i3 = i2; g2 = s; i2 = j; }
            else if (s > g3) { g3 = s; i3 = j; }
        }
        if (i1 >= 0) mask |= 1u << i1;
        if (i2 >= 0) mask |= 1u << i2;
        if (i3 >= 0) mask |= 1u << i3;
    }
    float mx = -INFINITY, l = 0.f, o[32];
#pragma unroll
    for (int d = 0; d < 32; ++d) o[d] = 0.f;
    for (int j = 0; j <= qb; ++j) {
        __syncthreads();
        {
            const int r = F.tid >> 1, hf = F.tid & 1; const size_t row = (size_t)b * SEQ + j * 256 + r;
            float tmp[32];
            ld32bf(F.zc + row * ZC + ZK + h * 64 + hf * 32, tmp);
#pragma unroll
            for (int d = 0; d < 32; d += 4) *(LAS f32x4*)(Ks + r * 64 + hf * 32 + d) = (f32x4){tmp[d], tmp[d + 1], tmp[d + 2], tmp[d + 3]};
            ld32bf(F.zc + row * ZC + ZV + h * 64 + hf * 32, tmp);
#pragma unroll
            for (int d = 0; d < 32; d += 4) *(LAS f32x4*)(Vs + r * 64 + hf * 32 + d) = (f32x4){tmp[d], tmp[d + 1], tmp[d + 2], tmp[d + 3]};
        }
        __syncthreads();
        const bool take = (j == qb) || ((mask >> j) & 1u);
        if (take) {
            const int nkeys = (j == qb) ? (ql + 1) : 256;
            for (int key = 0; key < nkeys; ++key) {
                const LAS f32x4* kp = (const LAS f32x4*)(Ks + key * 64 + half * 32);
                float s = 0.f;
#pragma unroll
                for (int d4 = 0; d4 < 8; ++d4) { const f32x4 kv = kp[d4]; s += q[4 * d4] * kv.x + q[4 * d4 + 1] * kv.y + q[4 * d4 + 2] * kv.z + q[4 * d4 + 3] * kv.w; }
                s += __shfl_xor(s, 1);
                s -= sl2 * (float)(t - (j * 256 + key));
                if (s > mx) { const float a = exp2f(mx - s); l *= a;
#pragma unroll
                    for (int d = 0; d < 32; ++d) o[d] *= a;
                    mx = s; }
                const float p = exp2f(s - mx); l += p;
                const LAS f32x4* vp = (const LAS f32x4*)(Vs + key * 64 + half * 32);
#pragma unroll
                for (int d4 = 0; d4 < 8; ++d4) { const f32x4 vv = vp[d4]; o[4 * d4] += p * vv.x; o[4 * d4 + 1] += p * vv.y; o[4 * d4 + 2] += p * vv.z; o[4 * d4 + 3] += p * vv.w; }
            }
        }
    }
    const float inv = 1.0f / l;
#pragma unroll
    for (int i = 0; i < 4; ++i) { v4u w; w.x = pk2(o[8 * i] * inv, o[8 * i + 1] * inv); w.y = pk2(o[8 * i + 2] * inv, o[8 * i + 3] * inv);
        w.z = pk2(o[8 * i + 4] * inv, o[8 * i + 5] * inv); w.w = pk2(o[8 * i + 6] * inv, o[8 * i + 7] * inv); *(v4u*)(qp + 8 * i) = w; }
}
__device__ __forceinline__ void p4_attn_simple(Frame& F) {
    for (int v = blockIdx.x; v < 256; v += F.G) {
        const int bh = v >> 4, s = v & 15;
        attn_simple_unit(F, bh >> 3, bh & 7, s);
        attn_simple_unit(F, bh >> 3, bh & 7, 31 - s);
    }
    __syncthreads();
}

__device__ __forceinline__ void p7_ln(Frame& F) {
    const int gw = blockIdx.x * NWAVES + F.wave, NGW = F.G * NWAVES;
    for (int m = gw; m < M; m += NGW) {
        const int b = m >> 13;
        f32x4* xr = (f32x4*)(F.out + (size_t)m * D) + F.lane;
        f32x4 v[4]; float s = 0.f;
#pragma unroll
        for (int j = 0; j < 4; ++j) { v[j] = xr[64 * j]; s += (v[j].x + v[j].y) + (v[j].z + v[j].w); }
        float mean = wave_sum(s) * (1.f / D); float s2 = 0.f;
#pragma unroll
        for (int j = 0; j < 4; ++j) { v[j] = v[j] - mean; s2 += (v[j].x * v[j].x + v[j].y * v[j].y) + (v[j].z * v[j].z + v[j].w * v[j].w); }
        float rstd = 1.f / sqrtf(wave_sum(s2) * (1.f / D) + LN_EPS);
        s = 0.f;
#pragma unroll
        for (int j = 0; j < 4; ++j) {
            const int col = 4 * F.lane + 256 * j;
            v[j] = v[j] * rstd * *(const f32x4*)(F.ln1_g + col) + *(const f32x4*)(F.ln1_b + col);
            xr[64 * j] = v[j];
            s += (v[j].x + v[j].y) + (v[j].z + v[j].w);
        }
        mean = wave_sum(s) * (1.f / D); s2 = 0.f;
#pragma unroll
        for (int j = 0; j < 4; ++j) { v[j] = v[j] - mean; s2 += (v[j].x * v[j].x + v[j].y * v[j].y) + (v[j].z * v[j].z + v[j].w * v[j].w); }
        rstd = 1.f / sqrtf(wave_sum(s2) * (1.f / D) + LN_EPS);
        unsigned long long* o8 = (unsigned long long*)(F.xn + (size_t)m * D) + F.lane;
#pragma unroll
        for (int j = 0; j < 4; ++j) {
            const int col = 4 * F.lane + 256 * j;
            const f32x4 sh = *(const f32x4*)(F.mod + b * 6144 + 3072 + col), sc = *(const f32x4*)(F.mod + b * 6144 + 4096 + col);
            const f32x4 y = v[j] * rstd * (sc + 1.0f) + sh;
            o8[64 * j] = (unsigned long long)pk2(y.x, y.y) | ((unsigned long long)pk2(y.z, y.w) << 32);
        }
    }
}

__device__ __forceinline__ void ins16(float (&L)[16], float v) {
#pragma unroll
    for (int i = 15; i >= 1; --i) L[i] = __builtin_amdgcn_fmed3f(L[i - 1], L[i], v);
    L[0] = fmaxf(L[0], v);
}
__device__ __forceinline__ void p9_topk_simple(Frame& F) {
    LAS float* Kl = (LAS float*)F.lds;
    for (int u = blockIdx.x; u < 512; u += F.G) {
        const int hc = u & 15, tb = u >> 4;
        __syncthreads();
        for (int i = F.tid; i < 16384; i += NWAVES * 64) Kl[i] = F.sub_keys[(size_t)hc * 16384 + i];
        __syncthreads();
        const int t = tb * 512 + F.tid;
        const bf16* qp = F.pq + (size_t)t * PQC + hc * 128;
        float q[128];
#pragma unroll
        for (int i = 0; i < 16; ++i) { const v4u w = *(const v4u*)(qp + 8 * i);
            q[8 * i + 0] = bflo(w.x); q[8 * i + 1] = bfhi(w.x); q[8 * i + 2] = bflo(w.y); q[8 * i + 3] = bfhi(w.y);
            q[8 * i + 4] = bflo(w.z); q[8 * i + 5] = bfhi(w.z); q[8 * i + 6] = bflo(w.w); q[8 * i + 7] = bfhi(w.w); }
        float L[16];
#pragma unroll
        for (int i = 0; i < 16; ++i) L[i] = -INFINITY;
        for (int n = 0; n < 128; ++n) {
            const LAS f32x4* kp = (const LAS f32x4*)(Kl + n * 128);
            float d0 = 0.f, d1 = 0.f;
#pragma unroll
            for (int d4 = 0; d4 < 32; d4 += 2) { const f32x4 a = kp[d4], c = kp[d4 + 1];
                d0 += q[4 * d4] * a.x + q[4 * d4 + 1] * a.y + q[4 * d4 + 2] * a.z + q[4 * d4 + 3] * a.w;
                d1 += q[4 * d4 + 4] * c.x + q[4 * d4 + 5] * c.y + q[4 * d4 + 6] * c.z + q[4 * d4 + 7] * c.w; }
            const float dot = d0 + d1;
            ins16(L, __uint_as_float((__float_as_uint(dot) & ~127u) | (unsigned)n));
        }
        f32x4* o = (f32x4*)(F.ts + ((size_t)t * 16 + hc) * 16);
#pragma unroll
        for (int i = 0; i < 4; ++i) o[i] = (f32x4){L[4 * i], L[4 * i + 1], L[4 * i + 2], L[4 * i + 3]};
    }
    __syncthreads();
}

__device__ __forceinline__ void p9b_combine(Frame& F) {
    const int gt = blockIdx.x * (NWAVES * 64) + F.tid, NT = F.G * (NWAVES * 64);
    for (int i = gt; i < M * 8; i += NT) {
        const int t = i >> 3, h = i & 7;
        const float* l0 = F.ts + ((size_t)t * 16 + 2 * h) * 16; const float* l1 = l0 + 16;
        float A[16], B[16];
#pragma unroll
        for (int k = 0; k < 4; ++k) { const f32x4 a = ((const f32x4*)l0)[k], b = ((const f32x4*)l1)[k];
            A[4 * k] = a.x; A[4 * k + 1] = a.y; A[4 * k + 2] = a.z; A[4 * k + 3] = a.w; B[4 * k] = b.x; B[4 * k + 1] = b.y; B[4 * k + 2] = b.z; B[4 * k + 3] = b.w; }
#pragma unroll
        for (int k = 0; k < 16; ++k) { A[k] = __uint_as_float(__float_as_uint(A[k]) & ~127u); B[k] = __uint_as_float(__float_as_uint(B[k]) & ~127u); }
        float R[16];
#pragma unroll
        for (int k = 0; k < 16; ++k) R[k] = -INFINITY;
#pragma unroll
        for (int a = 0; a < 16; ++a)
#pragma unroll
            for (int b = 0; b < 16; ++b)
                if ((a + 1) * (b + 1) <= 16) ins16(R, __uint_as_float((__float_as_uint(A[a] + B[b]) & ~255u) | (unsigned)(a * 16 + b)));
        float e[16]; float sum = 0.f; const float r0 = __uint_as_float(__float_as_uint(R[0]) & ~255u);
#pragma unroll
        for (int k = 0; k < 16; ++k) { e[k] = __expf(__uint_as_float(__float_as_uint(R[k]) & ~255u) - r0); sum += e[k]; }
        const float inv = 1.0f / sum;
#pragma unroll
        for (int k = 0; k < 16; ++k) {
            const unsigned bits = __float_as_uint(R[k]); const int a = (bits >> 4) & 15, b = bits & 15;
            const int i1 = (int)(__float_as_uint(l0[a]) & 127u), i2 = (int)(__float_as_uint(l1[b]) & 127u);
            F.idx[(size_t)t * 128 + h * 16 + k] = i1 * 128 + i2;
            F.gw[(size_t)t * 128 + h * 16 + k] = e[k] * inv;
        }
    }
}

__device__ __forceinline__ void p10_peer_simple(Frame& F) {
    const int gw = blockIdx.x * NWAVES + F.wave, NGW = F.G * NWAVES;
    for (int m = gw; m < M; m += NGW) {
        const int b = m >> 13;
        float hrow[16];
        {   const bf16* hp = F.xn + (size_t)m * D + F.lane * 8;
            const v4u w0 = *(const v4u*)hp, w1 = *(const v4u*)(hp + 512);
            hrow[0] = bflo(w0.x); hrow[1] = bfhi(w0.x); hrow[2] = bflo(w0.y); hrow[3] = bfhi(w0.y); hrow[4] = bflo(w0.z); hrow[5] = bfhi(w0.z); hrow[6] = bflo(w0.w); hrow[7] = bfhi(w0.w);
            hrow[8] = bflo(w1.x); hrow[9] = bfhi(w1.x); hrow[10] = bflo(w1.y); hrow[11] = bfhi(w1.y); hrow[12] = bflo(w1.z); hrow[13] = bfhi(w1.z); hrow[14] = bflo(w1.w); hrow[15] = bfhi(w1.w); }
        float acc[16];
#pragma unroll
        for (int k = 0; k < 16; ++k) acc[k] = 0.f;
        const int* ip = F.idx + (size_t)m * 128; const float* gp = F.gw + (size_t)m * 128;
#pragma unroll 4
        for (int k = 0; k < 128; ++k) {
            const int e = __builtin_amdgcn_readfirstlane(ip[k]); const float g = __uint_as_float(__builtin_amdgcn_readfirstlane(__float_as_uint(gp[k])));
            const bf16* up = F.u16 + (size_t)e * D + F.lane * 8; const bf16* vp = F.v16 + (size_t)e * D + F.lane * 8;
            const v4u u0 = *(const v4u*)up, u1 = *(const v4u*)(up + 512);
            const v4u v0 = *(const v4u*)vp, v1 = *(const v4u*)(vp + 512);
            float dsum = hrow[0] * bflo(u0.x) + hrow[1] * bfhi(u0.x) + hrow[2] * bflo(u0.y) + hrow[3] * bfhi(u0.y) + hrow[4] * bflo(u0.z) + hrow[5] * bfhi(u0.z) + hrow[6] * bflo(u0.w) + hrow[7] * bfhi(u0.w)
                       + hrow[8] * bflo(u1.x) + hrow[9] * bfhi(u1.x) + hrow[10] * bflo(u1.y) + hrow[11] * bfhi(u1.y) + hrow[12] * bflo(u1.z) + hrow[13] * bfhi(u1.z) + hrow[14] * bflo(u1.w) + hrow[15] * bfhi(u1.w);
            dsum = wave_sum(dsum);
            const float w = g * gelu_erf(dsum);
            acc[0] += w * bflo(v0.x); acc[1] += w * bfhi(v0.x); acc[2] += w * bflo(v0.y); acc[3] += w * bfhi(v0.y); acc[4] += w * bflo(v0.z); acc[5] += w * bfhi(v0.z); acc[6] += w * bflo(v0.w); acc[7] += w * bfhi(v0.w);
            acc[8] += w * bflo(v1.x); acc[9] += w * bfhi(v1.x); acc[10] += w * bflo(v1.y); acc[11] += w * bfhi(v1.y); acc[12] += w * bflo(v1.z); acc[13] += w * bfhi(v1.z); acc[14] += w * bflo(v1.w); acc[15] += w * bfhi(v1.w);
        }
        float* xr = F.out + (size_t)m * D; float y[16]; float s = 0.f;
#pragma unroll
        for (int hh = 0; hh < 2; ++hh) {
            const int col = hh * 512 + F.lane * 8;
            const f32x4 xa = *(const f32x4*)(xr + col), xb = *(const f32x4*)(xr + col + 4);
            const f32x4 ga = *(const f32x4*)(F.mod + b * 6144 + 5120 + col), gb = *(const f32x4*)(F.mod + b * 6144 + 5120 + col + 4);
            y[8 * hh + 0] = ALPHA * xa.x + (1.f + ga.x) * acc[8 * hh + 0]; y[8 * hh + 1] = ALPHA * xa.y + (1.f + ga.y) * acc[8 * hh + 1];
            y[8 * hh + 2] = ALPHA * xa.z + (1.f + ga.z) * acc[8 * hh + 2]; y[8 * hh + 3] = ALPHA * xa.w + (1.f + ga.w) * acc[8 * hh + 3];
            y[8 * hh + 4] = ALPHA * xb.x + (1.f + gb.x) * acc[8 * hh + 4]; y[8 * hh + 5] = ALPHA * xb.y + (1.f + gb.y) * acc[8 * hh + 5];
            y[8 * hh + 6] = ALPHA * xb.z + (1.f + gb.z) * acc[8 * hh + 6]; y[8 * hh + 7] = ALPHA * xb.w + (1.f + gb.w) * acc[8 * hh + 7];
        }
#pragma unroll
        for (int k = 0; k < 16; ++k) s += y[k];
        const float mean = wave_sum(s) * (1.f / D); float s2 = 0.f;
#pragma unroll
        for (int k = 0; k < 16; ++k) { y[k] -= mean; s2 += y[k] * y[k]; }
        const float rstd = 1.f / sqrtf(wave_sum(s2) * (1.f / D) + LN_EPS);
#pragma unroll
        for (int hh = 0; hh < 2; ++hh) {
            const int col = hh * 512 + F.lane * 8;
            const f32x4 g0 = *(const f32x4*)(F.ln2_g + col), g1 = *(const f32x4*)(F.ln2_g + col + 4), b0 = *(const f32x4*)(F.ln2_b + col), b1 = *(const f32x4*)(F.ln2_b + col + 4);
            f32x4 o0, o1;
            o0.x = y[8 * hh + 0] * rstd * g0.x + b0.x; o0.y = y[8 * hh + 1] * rstd * g0.y + b0.y; o0.z = y[8 * hh + 2] * rstd * g0.z + b0.z; o0.w = y[8 * hh + 3] * rstd * g0.w + b0.w;
            o1.x = y[8 * hh + 4] * rstd * g1.x + b1.x; o1.y = y[8 * hh + 5] * rstd * g1.y + b1.y; o1.z = y[8 * hh + 6] * rstd * g1.z + b1.z; o1.w = y[8 * hh + 7] * rstd * g1.w + b1.w;
            *(f32x4*)(xr + col) = o0; *(f32x4*)(xr + col + 4) = o1;
        }
    }
}

struct FnZ {
    bf16* zc; bf16* gates;
    __device__ __forceinline__ void operator()(int row, int col, pg8::f32x4 v0, pg8::f32x4 v1, int pn) const {
        if (pn < 2) { v0 = v0 * C2; v1 = v1 * C2; }
        else if (pn >= 6 && pn < 10) { v0 = pg8::gelu4(v0); v1 = pg8::gelu4(v1); }
        else if (pn >= 10) { v0 = pg8::sigm4(v0); v1 = pg8::sigm4(v1); }
        bf16* dst = (pn < 10) ? zc + (size_t)row * ZC + col : gates + (size_t)row * GC + (col - ZC);
        *(pg8::u32x4*)dst = pg8::pack8(v0, v1);
    }
};
struct FnUpA {
    bf16* zc; const bf16* gates;
    __device__ __forceinline__ void operator()(int row, int col, pg8::f32x4 v0, pg8::f32x4 v1, int) const {
        pg8::f32x4 g0, g1; pg8::unpack8(*(const pg8::u32x4*)(gates + (size_t)row * GC + col), g0, g1);
        *(pg8::u32x4*)(zc + (size_t)row * ZC + 512 + col) = pg8::pack8(v0 * g0, v1 * g1);
    }
};
struct FnUpB {
    bf16* zc; const bf16* gates;
    __device__ __forceinline__ void operator()(int row, int col, pg8::f32x4 v0, pg8::f32x4 v1, int) const {
        pg8::f32x4 g0, g1, m0, m1; pg8::unpack8(*(const pg8::u32x4*)(gates + (size_t)row * GC + 1024 + col), g0, g1);
        bf16* p = zc + (size_t)row * ZC + 512 + col; pg8::unpack8(*(const pg8::u32x4*)p, m0, m1);
        *(pg8::u32x4*)p = pg8::pack8(m0 + v0 * g0, m1 + v1 * g1);
    }
};
struct FnV1 {
    const float* x; const float* mod; float* out;
    __device__ __forceinline__ void operator()(int row, int col, pg8::f32x4 v0, pg8::f32x4 v1, int) const {
        const int b = row >> 13; const float* gt = mod + b * 6144 + 2048 + col;
        const pg8::f32x4 x0 = *(const pg8::f32x4*)(x + (size_t)row * D + col), x1 = *(const pg8::f32x4*)(x + (size_t)row * D + col + 4);
        const pg8::f32x4 t0 = *(const pg8::f32x4*)gt, t1 = *(const pg8::f32x4*)(gt + 4);
        *(pg8::f32x4*)(out + (size_t)row * D + col) = x0 * ALPHA + (t0 + 1.0f) * v0;
        *(pg8::f32x4*)(out + (size_t)row * D + col + 4) = x1 * ALPHA + (t1 + 1.0f) * v1;
    }
};
struct FnPlain {
    bf16* o; int ldc;
    __device__ __forceinline__ void operator()(int row, int col, pg8::f32x4 v0, pg8::f32x4 v1, int) const { *(pg8::u32x4*)(o + (size_t)row * ldc + col) = pg8::pack8(v0, v1); }
};

constexpr int NPH = 12;
#ifndef MK_PER_PHASE
#define MK_PER_PHASE 0
#endif
struct Args { const float* in[20]; float* out; unsigned char* ws; int ph_lo, ph_hi; };
__global__ void __launch_bounds__(NWAVES * 64, 2) mk_fwd(Args args) {
    extern __shared__ __attribute__((aligned(16))) unsigned char lds[];
    Frame F;
    F.lds = (LAS unsigned char*)lds;
    F.MISC = (volatile LAS unsigned*)(F.lds + MISC_OFF);
    F.tid = threadIdx.x; F.lane = F.tid & 63; F.wave = __builtin_amdgcn_readfirstlane(F.tid >> 6); F.G = gridDim.x;
    unsigned char* ws = args.ws;
    F.ctl = (gu32*)(ws + WS_CTL);
    F.x = args.in[0]; F.c = args.in[1]; F.w_cond = args.in[2]; F.b_cond = args.in[3]; F.w_in = args.in[4]; F.w_attn_up = args.in[5]; F.w_gmlp_up = args.in[6]; F.w_out = args.in[7];
    F.sgu_ln_g = args.in[8]; F.sgu_ln_b = args.in[9]; F.w_spatial = args.in[10]; F.b_spatial = args.in[11]; F.ln1_g = args.in[12]; F.ln1_b = args.in[13]; F.w_peer_q = args.in[14];
    F.sub_keys = args.in[15]; F.peer_u = args.in[16]; F.peer_v = args.in[17]; F.ln2_g = args.in[18]; F.ln2_b = args.in[19];
    F.out = args.out;
    F.mod = (float*)(ws + WS_MOD); F.kmean = (float*)(ws + WS_KMEAN); F.ts = (float*)(ws + WS_TS); F.gw = (float*)(ws + WS_GW); F.idx = (int*)(ws + WS_IDX);
    F.win_t = (bf16*)(ws + WS_WIN); F.wa_t = (bf16*)(ws + WS_WA); F.wg_t = (bf16*)(ws + WS_WG); F.wout_t = (bf16*)(ws + WS_WOUT); F.wpq_t = (bf16*)(ws + WS_WPQ);
    F.u16 = (bf16*)(ws + WS_U16); F.v16 = (bf16*)(ws + WS_V16); F.xn = (bf16*)(ws + WS_XN); F.zc = (bf16*)(ws + WS_ZC); F.pq = (bf16*)(ws + WS_ZC); F.gates = (bf16*)args.out;
    for (int u = F.tid; u < (LDS_BYTES - LDSCTL_OFF) / 4; u += NWAVES * 64) ((LAS unsigned*)(F.lds + LDSCTL_OFF))[u] = 0u;
    __syncthreads();
    const int lo = args.ph_lo, hi = args.ph_hi;
    XcdBarrier bar; bar.bar = (unsigned*)(F.ctl + CW_BAR); bar.x = 0; bar.st = nullptr;
    if (hi - lo > 1) bar = xcd_barrier_post((unsigned*)(F.ctl + CW_BAR), F.MISC + 8);
#define IN(k) (lo <= (k) && (k) < hi)
#define SEAM(k) do { if (IN(k) && IN((k) + 1)) xcd_barrier(bar); } while (0)

    if (IN(0)) { p0_prologue(F); SEAM(0); }
    if (IN(1)) { p1_modulate(F); SEAM(1); }
    if (IN(2)) {
        pg8::Gemm g{F.xn, F.win_t, M, INC, D, D, D}; pg8::StaticOrder S; S.init(M, INC, F.G, (int)blockIdx.x);
        pg8::EpiFn<FnZ> E{FnZ{F.zc, F.gates}};
        pg8::gemm_phase<pg8::EpiFn<FnZ>, pg8::StaticOrder, true, true>(F.lds, g, S, E);
        SEAM(2);
    }
    if (IN(3)) { p3_kmean(F); p3_sgu(F); SEAM(3); }
    if (IN(4)) { p4_attn_simple(F); SEAM(4); }
    if (IN(5)) {
        { pg8::Gemm g{F.zc + ZQ, F.wa_t, M, D, 512, ZC, 512}; pg8::StaticOrder S; S.init(M, D, F.G, (int)blockIdx.x);
          pg8::EpiFn<FnUpA> E{FnUpA{F.zc, F.gates}};
          pg8::gemm_phase<pg8::EpiFn<FnUpA>, pg8::StaticOrder, true, true>(F.lds, g, S, E); }
        VM_WAIT(); __syncthreads();
        { pg8::Gemm g{F.zc + ZGU, F.wg_t, M, D, 512, ZC, 512}; pg8::StaticOrder S; S.init(M, D, F.G, (int)blockIdx.x);
          pg8::EpiFn<FnUpB> E{FnUpB{F.zc, F.gates}};
          pg8::gemm_phase<pg8::EpiFn<FnUpB>, pg8::StaticOrder, true, true>(F.lds, g, S, E); }
        SEAM(5);
    }
    if (IN(6)) {
        pg8::Gemm g{F.zc + 512, F.wout_t, M, D, D, ZC, D}; pg8::StaticOrder S; S.init(M, D, F.G, (int)blockIdx.x);
        pg8::EpiFn<FnV1> E{FnV1{F.x, F.mod, F.out}};
        pg8::gemm_phase<pg8::EpiFn<FnV1>, pg8::StaticOrder, true, true>(F.lds, g, S, E);
        SEAM(6);
    }
    if (IN(7)) { p7_ln(F); SEAM(7); }
    if (IN(8)) {
        pg8::Gemm g{F.xn, F.wpq_t, M, PQC, D, D, D}; pg8::StaticOrder S; S.init(M, PQC, F.G, (int)blockIdx.x);
        pg8::EpiFn<FnPlain> E{FnPlain{F.pq, PQC}};
        pg8::gemm_phase<pg8::EpiFn<FnPlain>, pg8::StaticOrder, true, true>(F.lds, g, S, E);
        SEAM(8);
    }
    if (IN(9)) { p9_topk_simple(F); SEAM(9); }
    if (IN(10)) { p9b_combine(F); SEAM(10); }
    if (IN(11)) { p10_peer_simple(F); }
#undef IN
#undef SEAM
}

extern "C" void kernel_launch(void* const* d_in, const int* in_sizes, int n_in, void* d_out, int out_size, void* d_ws, size_t ws_size, hipStream_t stream) {
    static int grid = 0;
    if (grid == 0) {
        if (n_in != 20 || in_sizes[0] != M * D || out_size != M * D || ws_size < WS_END) { fprintf(stderr, "kernel_launch: unexpected shapes (n_in %d, in0 %d, out %d, ws %zu); nothing launched\n", n_in, n_in > 0 ? in_sizes[0] : -1, out_size, ws_size); grid = -1; return; }
        int dev = 0, cus = 0;
        if (hipGetDevice(&dev) != hipSuccess || hipDeviceGetAttribute(&cus, hipDeviceAttributeMultiprocessorCount, dev) != hipSuccess) { grid = -1; return; }
        if (hipFuncSetAttribute((const void*)mk_fwd, hipFuncAttributeMaxDynamicSharedMemorySize, LDS_BYTES) != hipSuccess) { fprintf(stderr, "kernel_launch: hipFuncSetAttribute failed\n"); grid = -1; return; }
        (void)hipGetLastError();
        grid = cus < 256 ? cus : 256;
    }
    if (grid < 0) return;
    if (hipMemsetAsync((char*)d_ws + WS_CTL, 0, CTL_ZERO_BYTES, stream) != hipSuccess) return;
    Args a{};
    for (int i = 0; i < 20; ++i) a.in[i] = (const float*)d_in[i];
    a.out = (float*)d_out; a.ws = (unsigned char*)d_ws;
#if MK_PER_PHASE
    for (int p = 0; p < NPH; ++p) { a.ph_lo = p; a.ph_hi = p + 1; hipLaunchKernelGGL(mk_fwd, dim3(grid), dim3(NWAVES * 64), LDS_BYTES, stream, a); }
#else
    a.ph_lo = 0; a.ph_hi = NPH; hipLaunchKernelGGL(mk_fwd, dim3(grid), dim3(NWAVES * 64), LDS_BYTES, stream, a);
#endif
}
```

```cpp
#include <hip/hip_runtime.h>
#include <cstdio>
#include <cstdint>
#include <cmath>
__device__ __forceinline__ int mk_lane_id() { int l; asm volatile("v_mbcnt_lo_u32_b32 %0, -1, 0\n\tv_mbcnt_hi_u32_b32 %0, -1, %0" : "=v"(l)); return l; }
namespace pg8 {
#define PG8_LAS __attribute__((address_space(3)))
typedef unsigned short bf16_t;
typedef short bf16x8 __attribute__((ext_vector_type(8)));
typedef float f32x4 __attribute__((ext_vector_type(4)));
typedef unsigned u32x4 __attribute__((ext_vector_type(4)));
constexpr int BM = 256, BK = 64, HALF = 128, HTB = HALF * BK * 2  , STAGE_BYTES = 8 * HTB, NXCD = 8, WGM = 8;

__host__ __device__ __forceinline__ int lds_byte(int r, int c) { const int st = (r >> 4) * 2 + (c >> 5), rr = r & 15, cc = c & 31, ob = rr * 64 + cc * 2; return st * 1024 + (ob ^ (((ob >> 9) & 1) << 5)); }
__host__ __device__ __forceinline__ void stage_rc(int b, int& R, int& C) { const int st = b / 1024, sb = b % 1024, swz = sb ^ (((sb >> 9) & 1) << 5); R = (st >> 1) * 16 + swz / 64; C = (st & 1) * 32 + (swz % 64) / 2; }
__host__ __device__ __forceinline__ int perm32(int rho) { const int n = rho >> 4, i = rho & 15; return 8 * (i >> 2) + 4 * n + (i & 3); }

struct Unit { int pm, pn; };
struct Gemm { const bf16_t* A; const bf16_t* Bt; int M, N, K, lda, ldb; };

struct StaticOrder {
    int nM, nN, nwg, G, c;
    __host__ __device__ void init(int M, int N, int G_, int c_) { nM = M / BM; nN = N / BM; nwg = nM * nN; G = G_; c = c_; }
    __host__ __device__ bool next(int i, Unit& u) const {
        const long L = (long)i * G + c; if (L >= nwg) return false;
        int wgid = (int)L; { const int q = nwg / NXCD, r = nwg % NXCD, xcd = wgid % NXCD, off = wgid / NXCD; wgid = (xcd < r ? xcd * (q + 1) : r * (q + 1) + (xcd - r) * q) + off; }
        const int nig = WGM * nN, gid = wgid / nig, fm = gid * WGM, gsz = (nM - fm) < WGM ? (nM - fm) : WGM;
        u.pm = fm + ((wgid % nig) % gsz); u.pn = (wgid % nig) / gsz; return true;
    }
    __device__ __forceinline__ void a_ready(const Unit&) const {}
    __device__ __forceinline__ void done(const Unit&) const {}
};

__device__ __forceinline__ unsigned cvt_pk_bf16(float lo, float hi) { unsigned r; asm volatile("v_cvt_pk_bf16_f32 %0, %1, %2" : "=v"(r) : "v"(lo), "v"(hi)); return r; }
typedef float f32x2 __attribute__((ext_vector_type(2)));
__device__ __forceinline__ f32x2 gelu_pk(f32x2 v) {
    const f32x2 av = __builtin_elementwise_abs(v), d = av * 0.2316418882f + 1.0f;
    f32x2 t; t.x = __builtin_amdgcn_rcpf(d.x); t.y = __builtin_amdgcn_rcpf(d.y);
    f32x2 q = t * 0.5307027145f + (-0.7265760135f); q = q * t + 0.7107068705f; q = q * t + (-0.142248368f); q = q * t + 0.127414796f; q = q * t;
    const f32x2 s = (v * v) * (-0.72134752044f);
    f32x2 e; e.x = __builtin_amdgcn_exp2f(s.x); e.y = __builtin_amdgcn_exp2f(s.y);
    const f32x2 m = v * (q * e), r = v - m;
    f32x2 o; o.x = v.x < 0.f ? m.x : r.x; o.y = v.y < 0.f ? m.y : r.y; return o;
}

template <class Fn> struct EpiFn {
    static constexpr bool PERM = true, AFTER_DRAIN = false; Fn fn;
    __device__ __forceinline__ void operator()(const f32x4 (&acc)[2][2][4][2], const Unit& u, int wr, int wc, int fr, int fq) const {
        const int row0 = u.pm * BM + wr * 64 + fr, col0 = u.pn * BM + wc * 32 + 8 * fq;
#pragma unroll
        for (int ai = 0; ai < 2; ++ai)
#pragma unroll
            for (int m = 0; m < 4; ++m)
#pragma unroll
                for (int bj = 0; bj < 2; ++bj) fn(row0 + ai * HALF + m * 16, col0 + bj * HALF, acc[ai][bj][m][0], acc[ai][bj][m][1], u.pn);
    }
};
__device__ __forceinline__ u32x4 pack8(f32x4 v0, f32x4 v1) { u32x4 w; w.x = cvt_pk_bf16(v0[0], v0[1]); w.y = cvt_pk_bf16(v0[2], v0[3]); w.z = cvt_pk_bf16(v1[0], v1[1]); w.w = cvt_pk_bf16(v1[2], v1[3]); return w; }
__device__ __forceinline__ f32x4 gelu4(f32x4 v) { f32x2 a = gelu_pk((f32x2){v[0], v[1]}), b = gelu_pk((f32x2){v[2], v[3]}); return (f32x4){a.x, a.y, b.x, b.y}; }
__device__ __forceinline__ float sigm1(float x) { return __builtin_amdgcn_rcpf(1.0f + __builtin_amdgcn_exp2f(-1.4426950408889634f * x)); }
__device__ __forceinline__ f32x4 sigm4(f32x4 v) { return (f32x4){sigm1(v[0]), sigm1(v[1]), sigm1(v[2]), sigm1(v[3])}; }
__device__ __forceinline__ void unpack8(u32x4 w, f32x4& a, f32x4& b) {
    a = (f32x4){__uint_as_float(w.x << 16), __uint_as_float(w.x & 0xffff0000u), __uint_as_float(w.y << 16), __uint_as_float(w.y & 0xffff0000u)};
    b = (f32x4){__uint_as_float(w.z << 16), __uint_as_float(w.z & 0xffff0000u), __uint_as_float(w.w << 16), __uint_as_float(w.w & 0xffff0000u)};
}
template <class Epi, class Sched, bool ALIGN_EPI = false, bool SP2 = false>
__device__ __forceinline__ void gemm_phase(PG8_LAS unsigned char* lds, const Gemm g, const Sched& S, const Epi& E, const int wave_id  ) {
    const int wid = wave_id, lane = mk_lane_id(), tid = wid * 64 + lane, wr = wid >> 2, wc = wid & 3, fr = lane & 15, fq = lane >> 4;
    const int K = g.K, nt = K / BK;
    unsigned voffA[2], voffB[2];
#pragma unroll
    for (int i = 0; i < 2; ++i) { int R, C; stage_rc(tid * 16 + i * 8192, R, C); const int Rb = Epi::PERM ? ((R & ~31) + perm32(R & 31)) : R;
        voffA[i] = (unsigned)(R * g.lda + C) * 2u; voffB[i] = (unsigned)(Rb * g.ldb + C) * 2u; }
    const size_t kstep = (size_t)(BK * 2);
    const size_t hstepA = (size_t)HALF * g.lda * 2, hstepB = (size_t)HALF * g.ldb * 2;
    const size_t tstepA = 2 * hstepA, tstepB = 2 * hstepB;
    const unsigned ldsw = (unsigned)wid * 1024u;
    const int aoff = lds_byte(wr * 64 + fr, fq * 8), boff = lds_byte(wc * 32 + fr, fq * 8);
#define PG8_SA(b, h) (((b) * 2 + (h)) * HTB)
#define PG8_SB(b, h) ((4 + (b) * 2 + (h)) * HTB)
#define PG8_STAGE(bufoff, gbase, voff) do { _Pragma("unroll") for (int _i = 0; _i < 2; ++_i) \
        __builtin_amdgcn_global_load_lds((const unsigned*)((const char*)(gbase) + (voff)[_i]), (PG8_LAS unsigned*)(lds + (bufoff) + ldsw + _i * 8192), 16, 0, 0); } while (0)
#define PG8_LDA(dst, b, h) do { _Pragma("unroll") for (int m = 0; m < 4; ++m) _Pragma("unroll") for (int k = 0; k < 2; ++k) dst[m][k] = *(const PG8_LAS bf16x8*)(lds + PG8_SA(b, h) + aoff + m * 2048 + k * 1024); } while (0)
#define PG8_LDB(dst, b, h) do { _Pragma("unroll") for (int n = 0; n < 2; ++n) _Pragma("unroll") for (int k = 0; k < 2; ++k) dst[n][k] = *(const PG8_LAS bf16x8*)(lds + PG8_SB(b, h) + boff + n * 2048 + k * 1024); } while (0)
#define PG8_MMA(ai, bj, At, Bt) do { __builtin_amdgcn_s_setprio(1); _Pragma("unroll") for (int m = 0; m < 4; ++m) _Pragma("unroll") for (int n = 0; n < 2; ++n) _Pragma("unroll") for (int k = 0; k < 2; ++k) \
        acc[ai][bj][m][n] = __builtin_amdgcn_mfma_f32_16x16x32_bf16(Bt[n][k], At[m][k], acc[ai][bj][m][n], 0, 0, 0); __builtin_amdgcn_s_setprio(0); } while (0)
#define PG8_WAIT_V(n) asm volatile("s_waitcnt vmcnt(" #n ")" ::: "memory")
#define PG8_WAIT_L(n) asm volatile("s_waitcnt lgkmcnt(" #n ")" ::: "memory")
#define PG8_BAR __builtin_amdgcn_s_barrier()
#define PG8_SCHED __builtin_amdgcn_sched_barrier(0)
    Unit cur, nxt; int ui = 0;
    if (!S.next(0, cur)) return;
    f32x4 acc[2][2][4][2];
#pragma unroll
    for (int a = 0; a < 2; ++a)
#pragma unroll
        for (int b = 0; b < 2; ++b)
#pragma unroll
            for (int m = 0; m < 4; ++m)
#pragma unroll
                for (int n = 0; n < 2; ++n) acc[a][b][m][n] = (f32x4){0.f, 0.f, 0.f, 0.f};
    bf16x8 At[4][2], B0[2][2], B1[2][2];
    const char* cA = (const char*)g.A + (size_t)cur.pm * tstepA; const char* cB = (const char*)g.Bt + (size_t)cur.pn * tstepB;
    S.a_ready(cur);
    if constexpr (SP2) {
        PG8_STAGE(PG8_SB(0, 0), cB, voffB); PG8_STAGE(PG8_SB(0, 1), cB + hstepB, voffB); PG8_STAGE(PG8_SA(0, 0), cA, voffA); PG8_STAGE(PG8_SA(0, 1), cA + hstepA, voffA);
        if (wr == 1) PG8_BAR;
        PG8_WAIT_V(2); PG8_BAR;
        PG8_STAGE(PG8_SB(1, 0), cB + kstep, voffB); PG8_STAGE(PG8_SA(1, 0), cA + kstep, voffA); PG8_STAGE(PG8_SB(1, 1), cB + hstepB + kstep, voffB);
        PG8_WAIT_V(6); PG8_BAR;
    } else {
        PG8_STAGE(PG8_SB(0, 0), cB, voffB); PG8_STAGE(PG8_SA(0, 0), cA, voffA); PG8_STAGE(PG8_SB(0, 1), cB + hstepB, voffB); PG8_STAGE(PG8_SA(0, 1), cA + hstepA, voffA);
        if (wr == 1) PG8_BAR;
        PG8_WAIT_V(4); PG8_BAR;
        PG8_STAGE(PG8_SB(1, 0), cB + kstep, voffB); PG8_STAGE(PG8_SA(1, 0), cA + kstep, voffA); PG8_STAGE(PG8_SB(1, 1), cB + hstepB + kstep, voffB);
        PG8_WAIT_V(6); PG8_BAR;
    }
    for (;;) {
        const bool has_next = S.next(ui + 1, nxt);
        const char* nA = has_next ? (const char*)g.A + (size_t)nxt.pm * tstepA : cA; const char* nB = has_next ? (const char*)g.Bt + (size_t)nxt.pn * tstepB : cB;
        for (int t = 0; t < nt; t += 2) {
            const bool last = (t == nt - 2);
            const char* a1 = cA + (size_t)(t + 1) * kstep;
            const char* a2 = last ? nA : cA + (size_t)(t + 2) * kstep; const char* b2 = last ? nB : cB + (size_t)(t + 2) * kstep;
            const char* a3 = a2 + kstep; const char* b3 = b2 + kstep;
            if (last && has_next) S.a_ready(nxt);
            if constexpr (SP2) {
            PG8_LDB(B0, 0, 0); PG8_LDB(B1, 0, 1); PG8_SCHED; PG8_LDA(At, 0, 0); PG8_STAGE(PG8_SA(1, 1), a1 + hstepA, voffA);
            PG8_WAIT_V(8); PG8_WAIT_L(0); PG8_BAR; PG8_MMA(0, 0, At, B0); PG8_MMA(0, 1, At, B1); PG8_BAR; PG8_SCHED;
            PG8_LDA(At, 0, 1); PG8_STAGE(PG8_SB(0, 0), b2, voffB); PG8_STAGE(PG8_SB(0, 1), b2 + hstepB, voffB); PG8_STAGE(PG8_SA(0, 0), a2, voffA);
            PG8_WAIT_V(8); PG8_WAIT_L(0); PG8_BAR; PG8_MMA(1, 0, At, B0); PG8_MMA(1, 1, At, B1); PG8_BAR; PG8_SCHED;
            PG8_LDB(B0, 1, 0); PG8_LDB(B1, 1, 1); PG8_SCHED; PG8_LDA(At, 1, 0); PG8_STAGE(PG8_SA(0, 1), a2 + hstepA, voffA);
            PG8_WAIT_V(8); PG8_WAIT_L(0); PG8_BAR; PG8_MMA(0, 0, At, B0); PG8_MMA(0, 1, At, B1); PG8_BAR; PG8_SCHED;
            PG8_LDA(At, 1, 1); PG8_STAGE(PG8_SB(1, 0), b3, voffB); PG8_STAGE(PG8_SB(1, 1), b3 + hstepB, voffB); PG8_STAGE(PG8_SA(1, 0), a3, voffA);
            PG8_WAIT_V(8); PG8_WAIT_L(0); PG8_BAR; PG8_MMA(1, 0, At, B0); PG8_MMA(1, 1, At, B1); PG8_BAR; PG8_SCHED;
            } else {
            PG8_LDB(B0, 0, 0); PG8_SCHED; PG8_LDA(At, 0, 0); PG8_STAGE(PG8_SA(1, 1), a1 + hstepA, voffA);
            PG8_WAIT_L(8); PG8_BAR; PG8_WAIT_L(0); PG8_MMA(0, 0, At, B0); PG8_BAR; PG8_SCHED;
            PG8_LDB(B1, 0, 1); PG8_STAGE(PG8_SB(0, 0), b2, voffB);
            PG8_BAR; PG8_WAIT_L(0); PG8_MMA(0, 1, At, B1); PG8_BAR;
            PG8_LDA(At, 0, 1); PG8_STAGE(PG8_SA(0, 0), a2, voffA);
            PG8_BAR; PG8_WAIT_L(0); PG8_MMA(1, 0, At, B0); PG8_BAR; PG8_SCHED;
            PG8_STAGE(PG8_SB(0, 1), b2 + hstepB, voffB);
            PG8_WAIT_V(6); PG8_BAR; PG8_MMA(1, 1, At, B1); PG8_BAR;
            PG8_LDB(B0, 1, 0); PG8_SCHED; PG8_LDA(At, 1, 0); PG8_STAGE(PG8_SA(0, 1), a2 + hstepA, voffA);
            PG8_WAIT_L(8); PG8_BAR; PG8_WAIT_L(0); PG8_MMA(0, 0, At, B0); PG8_BAR; PG8_SCHED;
            PG8_LDB(B1, 1, 1); PG8_STAGE(PG8_SB(1, 0), b3, voffB);
            PG8_BAR; PG8_WAIT_L(0); PG8_MMA(0, 1, At, B1); PG8_BAR;
            PG8_LDA(At, 1, 1); PG8_STAGE(PG8_SA(1, 0), a3, voffA);
            PG8_BAR; PG8_WAIT_L(0); PG8_MMA(1, 0, At, B0); PG8_BAR; PG8_SCHED;
            PG8_STAGE(PG8_SB(1, 1), b3 + hstepB, voffB);
            PG8_WAIT_V(6); PG8_BAR; PG8_MMA(1, 1, At, B1); PG8_BAR;
            }
        }
        if constexpr (ALIGN_EPI) { if (wr == 0) PG8_BAR; }
        if constexpr (!Epi::AFTER_DRAIN) { E(acc, cur, wr, wc, fr, fq); S.done(cur); }
        if (!has_next) break;
#pragma unroll
        for (int a = 0; a < 2; ++a)
#pragma unroll
            for (int b = 0; b < 2; ++b)
#pragma unroll
                for (int m = 0; m < 4; ++m)
#pragma unroll
                    for (int n = 0; n < 2; ++n) acc[a][b][m][n] = (f32x4){0.f, 0.f, 0.f, 0.f};
        cur = nxt; cA = nA; cB = nB; ++ui;
        if constexpr (ALIGN_EPI) { if (wr == 1) PG8_BAR; }
    }
    PG8_WAIT_V(0);
    if constexpr (!ALIGN_EPI) { if (wr == 0) PG8_BAR; }
    PG8_BAR;
    if constexpr (Epi::AFTER_DRAIN) { E.fused(acc, cur, wr, wc, fr, fq, lds, wid, lane); S.done(cur); }
#undef PG8_SA
#undef PG8_SB
#undef PG8_STAGE
#undef PG8_LDA
#undef PG8_LDB
#undef PG8_MMA
#undef PG8_WAIT_V
#undef PG8_WAIT_L
#undef PG8_BAR
#undef PG8_SCHED
}
}
#define GAS __attribute__((address_space(1)))
#define LAS __attribute__((address_space(3)))
typedef unsigned short bf16;
typedef unsigned v4u __attribute__((ext_vector_type(4)));
typedef float f32x4 __attribute__((ext_vector_type(4)));
typedef short bf16x8 __attribute__((ext_vector_type(8)));
typedef GAS unsigned gu32;
typedef GAS unsigned long long gu64;
#define RLX_AGENT __ATOMIC_RELAXED, __HIP_MEMORY_SCOPE_AGENT
#define LDS_WAIT() asm volatile("s_waitcnt lgkmcnt(0)" ::: "memory")
#define VM_WAIT() asm volatile("s_waitcnt vmcnt(0)" ::: "memory")
__device__ __forceinline__ unsigned long long rt() { return __builtin_amdgcn_s_memrealtime(); }
__device__ __forceinline__ unsigned f2bf(float f) { unsigned u = __builtin_bit_cast(unsigned, f); return (u + 0x7fffu + ((u >> 16) & 1u)) >> 16; }
__device__ __forceinline__ unsigned pk2(float lo, float hi) { return f2bf(lo) | (f2bf(hi) << 16); }

#define XB_TMO      128
#define XB_XCNT(j)  (256  + 64 * (j))
#define XB_XSUB(j)  (1280 + 64 * (j))
#define XB_XGEN(j)  (2304 + 64 * (j))
#define XB_TOP      3328
#define XB_TOPGEN   3392
#define XCD_BAR_WORDS 3456
#define XB_SPIN_CAP (1u << 18)

__device__ __forceinline__ unsigned xb_ld(unsigned* p)              { return __hip_atomic_load(p, __ATOMIC_RELAXED, __HIP_MEMORY_SCOPE_AGENT); }
__device__ __forceinline__ unsigned xb_add(unsigned* p, unsigned v) { return __hip_atomic_fetch_add(p, v, __ATOMIC_RELAXED, __HIP_MEMORY_SCOPE_AGENT); }
__device__ __forceinline__ unsigned xb_xcc_id() { return (unsigned)__builtin_amdgcn_s_getreg((3 << 11) | 20) & 0xFu; }
#define XB_SPIN(cond, bar) do { unsigned _sp = 0; while (cond) { __builtin_amdgcn_s_sleep(1); \
    if ((++_sp & 255u) == 0u) { if (xb_ld(&(bar)[XB_TMO])) break; if (_sp > XB_SPIN_CAP) { atomicAdd(&(bar)[XB_TMO], 1u); break; } } } } while (0)

struct XcdBarrier {
    unsigned* bar; unsigned x; int wave;
    volatile LAS unsigned* st;
};

__device__ __forceinline__ XcdBarrier xcd_barrier_post(unsigned* bar, volatile LAS unsigned* st, int wave) {
    XcdBarrier b; b.bar = bar; b.x = xb_xcc_id(); b.st = st; b.wave = wave;
    if (wave == 0 && mk_lane_id() == 0) (void)xb_add(&bar[XB_XCNT(b.x)], 1u);
    return b;
}
__device__ __forceinline__ void xcd_barrier_complete(unsigned* bar, unsigned x, unsigned& nloc, unsigned& nx) {
    const unsigned G = gridDim.x * gridDim.y * gridDim.z;
    unsigned sum, cnt, mine, sp = 0u;
    for (;;) {
        sum = 0u; cnt = 0u; mine = 0u;
#pragma unroll
        for (unsigned j = 0; j < 16; ++j) { const unsigned c = xb_ld(&bar[XB_XCNT(j)]); sum += c; cnt += (c > 0u) ? 1u : 0u; mine = (j == x) ? c : mine; }
        if (sum == G) break;
        __builtin_amdgcn_s_sleep(1);
        if ((++sp & 255u) == 0u) { if (xb_ld(&bar[XB_TMO])) break; if (sp > XB_SPIN_CAP) { atomicAdd(&bar[XB_TMO], 1u); break; } }
    }
    nloc = mine > 0u ? mine : 1u; nx = cnt > 0u ? cnt : 1u;
}

__device__ __forceinline__ void xcd_barrier(const XcdBarrier& b) {
    asm volatile("s_waitcnt vmcnt(0)" ::: "memory");
    __syncthreads();
    if (b.wave == 0 && mk_lane_id() == 0) {
        unsigned* bar = b.bar;
        __builtin_amdgcn_s_waitcnt(0);
        unsigned nloc = b.st[0], nx = b.st[1];
        if (nloc == 0u) { xcd_barrier_complete(bar, b.x, nloc, nx); b.st[0] = nloc; b.st[1] = nx; }
        const unsigned old = xb_add(&bar[XB_XSUB(b.x)], 1u);
        const unsigned gen = old / nloc;
        if (old + 1u == (gen + 1u) * nloc) {
            __builtin_amdgcn_fence(__ATOMIC_RELEASE, "agent");
            asm volatile("s_waitcnt vmcnt(0)" ::: "memory");
            const unsigned og = xb_add(&bar[XB_TOP], 1u);
            const unsigned tg = og / nx;
            if (og + 1u == (tg + 1u) * nx) xb_add(&bar[XB_TOPGEN], 1u);
            else XB_SPIN(xb_ld(&bar[XB_TOPGEN]) == tg, bar);
            __builtin_amdgcn_fence(__ATOMIC_ACQUIRE, "agent");
            xb_add(&bar[XB_XGEN(b.x)], 1u);
            asm volatile("s_waitcnt vmcnt(0)" ::: "memory");
        } else {
            XB_SPIN(xb_ld(&bar[XB_XGEN(b.x)]) == gen, bar);
            __builtin_amdgcn_fence(__ATOMIC_ACQUIRE, "agent");
            asm volatile("s_waitcnt vmcnt(0)" ::: "memory");
        }
    }
    __syncthreads();
}
#include <hip/hip_bf16.h>
#include <cmath>
namespace attn_body {
using bf16=__hip_bfloat16;
using bf16x8=__attribute__((ext_vector_type(8)))short;
using s16x4=__attribute__((ext_vector_type(4)))short;
using f32x16=__attribute__((ext_vector_type(16)))float;
using u32x4=__attribute__((ext_vector_type(4)))unsigned;
constexpr int BATCH=2,NHEAD=8,SEQ=8192,D=64,DM=2560;
constexpr int NW=8,QBLK=32,QB=QBLK*NW,KVBLK=64,NQB=SEQ/QB;
constexpr int ATTN_PITCH=DM, ATTN_UNIT_ROWS=QB;
__device__ __forceinline__ int crow(int r,int hi){return (r&3)+8*(r>>2)+4*hi;}
#define SBAR() __builtin_amdgcn_sched_barrier(0)
__device__ __forceinline__ void cmask(f32x16&p0,f32x16&p1,int jb,int qrel,int hi){
  const float NEG=-INFINITY; int kb=64*jb+4*hi;
  #pragma unroll
  for(int r=0;r<16;++r){int kv=kb+(r&3)+8*(r>>2); if(kv>qrel)p0[r]=NEG; if(kv+32>qrel)p1[r]=NEG;}
}

__device__ __forceinline__ float uni_f(float v){ float r; asm volatile("s_nop 1\n\tv_readfirstlane_b32 %0, %1\n\ts_nop 3" : "=s"(r) : "v"(v)); return r; }
constexpr int NSLOT=3, SLOTB=8192;
constexpr int LDS_K=0, LDS_V=NSLOT*SLOTB, LDS_WS=2*NSLOT*SLOTB, LDS_OST=LDS_WS+NW*64*4, LDS_BYTES=LDS_OST+NW*4096, LDS_KMI=86016  ;
constexpr float C2=0.125f*1.4426950408889634f;
__device__ __forceinline__ void glds16(const void*gsrc,unsigned lds_dst){unsigned keep;
  asm volatile("s_mov_b32 %0, m0\n\ts_mov_b32 m0, %2\n\ts_nop 0\n\tglobal_load_lds_dwordx4 %1, off\n\ts_mov_b32 m0, %0":"=&s"(keep):"v"(gsrc),"s"(lds_dst):"memory");}
__device__ __forceinline__ float max3f(float a,float b,float c){float r;asm("v_max3_f32 %0, %1, %2, %3":"=v"(r):"v"(a),"v"(b),"v"(c));return r;}
__device__ __forceinline__ float max2f(float a,float b){float r;asm("v_max_f32_e32 %0, %1, %2":"=v"(r):"v"(a),"v"(b));return r;}
__device__ __forceinline__ float fadd_s(float a,float b){float r;asm("v_add_f32_e32 %0, %1, %2":"=v"(r):"v"(a),"v"(b));return r;}
__device__ __forceinline__ float fsub_s(float a,float b){float r;asm("v_sub_f32_e32 %0, %1, %2":"=v"(r):"v"(a),"v"(b));return r;}
typedef float f32x2_t __attribute__((ext_vector_type(2))); typedef __bf16 bf16x2_t __attribute__((ext_vector_type(2)));
__device__ __forceinline__ unsigned cvtpk_s(float lo,float hi){f32x2_t v={lo,hi};bf16x2_t b=__builtin_convertvector(v,bf16x2_t);return __builtin_bit_cast(unsigned,b);}
#define WAIT_BAR(N) asm volatile("s_waitcnt vmcnt(" #N ") lgkmcnt(0)\n\ts_barrier":::"memory")

__device__ __forceinline__ void qkt(f32x16&p0,f32x16&p1,const char*Kslot,const bf16x8*qr,const f32x16&negm,int r32,int hi){
  const char*kb=Kslot+hi*1024+r32*16;
  #pragma unroll
  for(int d0=0;d0<4;++d0){
    const bf16x8 b0=*reinterpret_cast<const bf16x8*>(kb+d0*2048);
    const bf16x8 b1=*reinterpret_cast<const bf16x8*>(kb+d0*2048+512);
    if(d0==0){p0=__builtin_amdgcn_mfma_f32_32x32x16_bf16(b0,qr[0],negm,0,0,0);p1=__builtin_amdgcn_mfma_f32_32x32x16_bf16(b1,qr[0],negm,0,0,0);}
    else{p0=__builtin_amdgcn_mfma_f32_32x32x16_bf16(b0,qr[d0],p0,0,0,0);p1=__builtin_amdgcn_mfma_f32_32x32x16_bf16(b1,qr[d0],p1,0,0,0);}}
}
typedef __attribute__((address_space(3))) const char* lds_cptr;
typedef short v4i16_t __attribute__((ext_vector_type(4)));
__device__ __forceinline__ void kload8(bf16x8*kf,lds_cptr kp){
  kf[0]=*(const __attribute__((address_space(3))) bf16x8*)(kp);      kf[1]=*(const __attribute__((address_space(3))) bf16x8*)(kp+512);
  kf[2]=*(const __attribute__((address_space(3))) bf16x8*)(kp+2048); kf[3]=*(const __attribute__((address_space(3))) bf16x8*)(kp+2560);
  kf[4]=*(const __attribute__((address_space(3))) bf16x8*)(kp+4096); kf[5]=*(const __attribute__((address_space(3))) bf16x8*)(kp+4608);
  kf[6]=*(const __attribute__((address_space(3))) bf16x8*)(kp+6144); kf[7]=*(const __attribute__((address_space(3))) bf16x8*)(kp+6656);
}
__device__ __forceinline__ void kload2(bf16x8*kf,lds_cptr kp,int j){ kf[2*j]=*(const __attribute__((address_space(3))) bf16x8*)(kp+j*2048); kf[2*j+1]=*(const __attribute__((address_space(3))) bf16x8*)(kp+j*2048+512); }
__device__ __forceinline__ s16x4 vtr(lds_cptr p){ return __builtin_bit_cast(s16x4,__builtin_amdgcn_ds_read_tr16_b64_v4i16((__attribute__((address_space(3))) v4i16_t*)p)); }
__device__ __forceinline__ float rowmax(const f32x16&p0,const f32x16&p1){
  float a=max3f(p0[0],p0[1],p1[0]),b=max3f(p0[2],p0[3],p1[1]);a=max3f(a,p1[2],p1[3]);
  #pragma unroll
  for(int r=4;r<16;r+=4){a=max3f(a,p0[r],p0[r+1]);b=max3f(b,p0[r+2],p0[r+3]);a=max3f(a,p1[r],p1[r+1]);b=max3f(b,p1[r+2],p1[r+3]);}
  const float m=max2f(a,b);
  auto rr=__builtin_amdgcn_permlane32_swap(__float_as_uint(m),__float_as_uint(m),false,false);
  return max2f(__uint_as_float(rr[0]),__uint_as_float(rr[1]));
}
__device__ __forceinline__ void pv(f32x16*o,int vb,bf16x8 pa0,bf16x8 pa1,bf16x8 pa2,bf16x8 pa3){
  #pragma unroll
  for(int d0=0;d0<2;++d0){s16x4 lo[4],hi[4];
    #pragma unroll
    for(int ks=0;ks<4;++ks){
      asm volatile("ds_read_b64_tr_b16 %0,%1 offset:%c2":"=&v"(lo[ks]):"v"(vb),"i"(d0*4096+ks*1024):"memory");
      asm volatile("ds_read_b64_tr_b16 %0,%1 offset:%c2":"=&v"(hi[ks]):"v"(vb),"i"(d0*4096+ks*1024+512):"memory");}
    asm volatile("s_waitcnt lgkmcnt(0)":::"memory");SBAR();
    #define PK(k) (bf16x8){lo[k][0],lo[k][1],lo[k][2],lo[k][3],hi[k][0],hi[k][1],hi[k][2],hi[k][3]}
    o[d0]=__builtin_amdgcn_mfma_f32_32x32x16_bf16(pa0,PK(0),o[d0],0,0,0);
    o[d0]=__builtin_amdgcn_mfma_f32_32x32x16_bf16(pa1,PK(1),o[d0],0,0,0);
    o[d0]=__builtin_amdgcn_mfma_f32_32x32x16_bf16(pa2,PK(2),o[d0],0,0,0);
    o[d0]=__builtin_amdgcn_mfma_f32_32x32x16_bf16(pa3,PK(3),o[d0],0,0,0);
    #undef PK
  }
}

#ifndef ATTN_STORE16
#define ATTN_STORE16(p,v) (*(u32x4*)(p)=(v))
#endif
template<int THRL> __device__ __forceinline__ void attn_unit(int b,int h,int qb,const bf16*Q,const bf16*__restrict__ K,const bf16*__restrict__ V,bf16*O,const unsigned short*kmi,char*shm,const int wave_id){
  const int wid=wave_id,lane=mk_lane_id(),tid=wid*64+lane,r32=lane&31,hi=lane>>5;
  const long rowbase=(long)b*SEQ; const int q0=qb*QB;
  const bf16*Qw=Q+(rowbase+q0+wid*QBLK)*DM+h*D;
  const bf16*Kh=K+rowbase*DM+h*D,*Vh=V+rowbase*DM+h*D;
  const unsigned lds0=(unsigned)(uintptr_t)shm;
  float*wsf=(float*)(shm+LDS_WS)+wid*64;
  const bf16*ksrc=Kh+(long)lane*DM+wid*8;
  const bf16*vsrc=Vh+(long)(16*(wid&3)+(lane>>2))*DM+(wid>>2)*32+(lane&3)*8;
  const unsigned kdst=lds0+LDS_K+wid*1024, vdst=lds0+LDS_V+wid*1024;
  #define DMA_K(t,slot) glds16(ksrc+(long)(t)*KVBLK*DM,(unsigned)__builtin_amdgcn_readfirstlane(kdst+(slot)))
  #define DMA_V(t,slot) glds16(vsrc+(long)(t)*KVBLK*DM,(unsigned)__builtin_amdgcn_readfirstlane(vdst+(slot)))
  const int vb0=(int)(lds0+LDS_V)+((lane>>4)&1)*32+(lane&3)*8+(4*hi+((lane&15)>>2))*64;
  const char*Kbase=shm+LDS_K; bf16x8 kf[8];
  const lds_cptr shm3=(lds_cptr)shm; const lds_cptr kp0=shm3+LDS_K+hi*1024+r32*16; const lds_cptr vp0=shm3+LDS_V+((lane>>4)&1)*32+(lane&3)*8+(4*hi+((lane&15)>>2))*64;
  const int NT=(q0+QB)/KVBLK;
  DMA_K(0,0);DMA_V(0,0);DMA_K(1,SLOTB);
  bf16x8 qr[4];
  #pragma unroll
  for(int d0=0;d0<4;++d0)qr[d0]=*reinterpret_cast<const bf16x8*>(&Qw[(long)r32*DM+d0*16+hi*8]);
  if(tid<256)*(u32x4*)(shm+LDS_KMI+tid*16)=*(const u32x4*)(kmi+tid*8);
  const float sl=__builtin_amdgcn_exp2f(-(float)(h+1))*1.4426950408889634f;
  #define UNI(x) uni_f((float)(x))
  const float W41=UNI(__builtin_amdgcn_exp2f(sl)),W42=UNI(__builtin_amdgcn_exp2f(2.f*sl)),W43=UNI(__builtin_amdgcn_exp2f(3.f*sl));
  const float W81=UNI(__builtin_amdgcn_exp2f(8.f*sl)),W82=UNI(__builtin_amdgcn_exp2f(16.f*sl)),W83=UNI(__builtin_amdgcn_exp2f(24.f*sl));
  const float E32=UNI(__builtin_amdgcn_exp2f(32.f*sl)),sl64=UNI(64.f*sl),E4=UNI(__builtin_amdgcn_exp2f(4.f*sl));
  const float rE32=UNI(__builtin_amdgcn_exp2f(-32.f*sl));
  unsigned mask=0u;
  const int qrel=wid*QBLK+r32;
  #define CMASK(P0,P1,t) do{int jb_=(t)-(NT-4); if(jb_>=0)cmask(P0,P1,jb_,qrel,hi);}while(0)
  bool resc=false;
  #define SETNEG(t) do{ const bool sel_=((t)>=NT-4)||(((mask>>((t)>>2))&1u)!=0u); const float v_=sel_?nm:-INFINITY; \
    _Pragma("unroll") for(int r=0;r<16;++r)negm[r]=v_; asm volatile("":"+v"(negm)); }while(0)
  #define RESC() do{ if(resc){ asm volatile("s_waitcnt lgkmcnt(0)":::"memory"); \
      _Pragma("unroll") for(int d_=0;d_<2;++d_) _Pragma("unroll") for(int r=0;r<16;++r)o[d_][r]*=wsf[crow(r,hi)]; } }while(0)
  f32x16 pA0,pA1,pB0,pB1;
  int sl_prev=0,sl_cur=0,sl_next=SLOTB;
  #define ROT() do{sl_prev=sl_cur;sl_cur=sl_next;sl_next=(sl_next==(NSLOT-1)*SLOTB)?0:sl_next+SLOTB;}while(0)
  DMA_K(2,2*SLOTB);
  WAIT_BAR(3);
  float z0_; asm volatile("v_mov_b32 %0, 0":"=v"(z0_)); f32x16 zero16; _Pragma("unroll") for(int r=0;r<16;++r)zero16[r]=z0_;
  { f32x16 g=zero16; const char*kmb=shm+LDS_KMI+hi*512+r32*16;
    #pragma unroll
    for(int d0=0;d0<4;++d0){const bf16x8 a=*reinterpret_cast<const bf16x8*>(kmb+d0*1024); g=__builtin_amdgcn_mfma_f32_32x32x16_bf16(a,qr[d0],g,0,0,0);}
    float g1=-INFINITY,g2=-INFINITY,g3=-INFINITY;
    #pragma unroll
    for(int r=0;r<16;++r){const int j=crow(r,hi); float v=__uint_as_float((__float_as_uint(g[r])&~31u)|(unsigned)(31-j)); v=(j<qb)?v:-INFINITY;
      g3=__builtin_amdgcn_fmed3f(g2,g3,v); g2=__builtin_amdgcn_fmed3f(g1,g2,v); g1=__builtin_fmaxf(g1,v);}
    float t1=-INFINITY,t2=-INFINITY,t3=-INFINITY;
    #define INS3(v) do{const float v_=(v); t3=__builtin_amdgcn_fmed3f(t2,t3,v_); t2=__builtin_amdgcn_fmed3f(t1,t2,v_); t1=__builtin_fmaxf(t1,v_);}while(0)
    {auto rr=__builtin_amdgcn_permlane32_swap(__float_as_uint(g1),__float_as_uint(g1),false,false);INS3(__uint_as_float(rr[0]));INS3(__uint_as_float(rr[1]));}
    {auto rr=__builtin_amdgcn_permlane32_swap(__float_as_uint(g2),__float_as_uint(g2),false,false);INS3(__uint_as_float(rr[0]));INS3(__uint_as_float(rr[1]));}
    {auto rr=__builtin_amdgcn_permlane32_swap(__float_as_uint(g3),__float_as_uint(g3),false,false);INS3(__uint_as_float(rr[0]));INS3(__uint_as_float(rr[1]));}
    #undef INS3
    if(t1>-INFINITY)mask|=1u<<(31u-(__float_as_uint(t1)&31u));
    if(t2>-INFINITY)mask|=1u<<(31u-(__float_as_uint(t2)&31u));
    if(t3>-INFINITY)mask|=1u<<(31u-(__float_as_uint(t3)&31u)); }
  float nm=-sl*(float)q0,l_reg=0.f;f32x16 o[2];o[0]=zero16;o[1]=zero16;f32x16 negm=zero16;asm volatile("":"+v"(negm));
  SETNEG(0);
  qkt(pA0,pA1,Kbase,qr,negm,r32,hi);asm volatile("s_nop 15\n\ts_nop 7":"+v"(pA0),"+v"(pA1));CMASK(pA0,pA1,0);
  { const float rm=rowmax(pA0,pA1); const float dl=__builtin_fmaxf(rm,0.f); nm-=dl;
    _Pragma("unroll") for(int r=0;r<16;++r){pA0[r]-=dl;pA1[r]-=dl;} }
  _Pragma("unroll") for(int r=0;r<16;++r)pA0[r]=__builtin_amdgcn_exp2f(pA0[r]);
  _Pragma("unroll") for(int r=0;r<16;++r)pA1[r]=__builtin_amdgcn_exp2f(pA1[r]);
  nm+=sl64;
  WAIT_BAR(0);
  DMA_K(3,0);DMA_V(1,SLOTB);
  ROT();
  kload8(kf,kp0+sl_cur);
  WAIT_BAR(2);
  s16x4 vlo[8],vhi[8]; u32x4 pw0,pw1,pw2,pw3;
  #define PKW(P,B) cvtpk_s(P[B],P[B+1])
  #define PAF(k) __builtin_bit_cast(bf16x8,pw##k)
  #define VFR(i) (bf16x8){vlo[i][0],vlo[i][1],vlo[i][2],vlo[i][3],vhi[i][0],vhi[i][1],vhi[i][2],vhi[i][3]}
  #define PIN(x) asm volatile("":"+v"(x))
  #define MX3(a,b,c) __builtin_fmaxf(__builtin_fmaxf((a),(b)),(c))
  #define QS(P,b) __builtin_fmaf(P[4*(b)+3],W43,__builtin_fmaf(P[4*(b)+2],W42,__builtin_fmaf(P[4*(b)+1],W41,P[4*(b)])))
  #define GAPA(MF,F0,W0,W1,PW) do{ MF; F0; PIN(sacc); W0; W1; PIN(PW); SBAR(); }while(0)
  #define EX(v) __builtin_amdgcn_exp2f(v)
  #define GAPB(MF,X,B) do{ MF; X[B]=EX(X[B]); X[B+1]=EX(X[B+1]); X[B+2]=EX(X[B+2]); X[B+3]=EX(X[B+3]); PIN(X); SBAR(); }while(0)
  #define VRD(i) do{ vlo[i]=vtr(vp_+(((i)>>2)*4096+((i)&3)*1024)); vhi[i]=vtr(vp_+(((i)>>2)*4096+((i)&3)*1024+512)); }while(0)
  #define KRD(G,j) do{ if(G){ kload2(kf,kp0+sl_next,j); SBAR(); } }while(0)
  #define STEP(C0,C1,P0,P1,t,GK,GV,GL) do{ SBAR(); \
    const lds_cptr vp_=vp0+sl_prev; \
    SETNEG(t); \
    VRD(0); SBAR(); float sacc; \
    GAPA(C0=__builtin_amdgcn_mfma_f32_32x32x16_bf16(kf[0],qr[0],negm,0,0,0), sacc=QS(P0,0),                                   pw0[0]=PKW(P0,0), pw0[1]=PKW(P0,2), pw0); \
    VRD(4); SBAR(); GAPA(C1=__builtin_amdgcn_mfma_f32_32x32x16_bf16(kf[1],qr[0],negm,0,0,0), sacc=__builtin_fmaf(QS(P0,1),W81,sacc),   pw0[2]=PKW(P0,4), pw0[3]=PKW(P0,6), pw0); \
    VRD(1); SBAR(); GAPA(C0=__builtin_amdgcn_mfma_f32_32x32x16_bf16(kf[2],qr[1],C0,0,0,0),   sacc=__builtin_fmaf(QS(P0,2),W82,sacc),   pw1[0]=PKW(P0,8), pw1[1]=PKW(P0,10), pw1); \
    VRD(5); SBAR(); GAPA(C1=__builtin_amdgcn_mfma_f32_32x32x16_bf16(kf[3],qr[1],C1,0,0,0),   sacc=__builtin_fmaf(QS(P0,3),W83,sacc)*rE32, pw1[2]=PKW(P0,12),pw1[3]=PKW(P0,14), pw1); \
    VRD(2); SBAR(); GAPA(C0=__builtin_amdgcn_mfma_f32_32x32x16_bf16(kf[4],qr[2],C0,0,0,0),   sacc+=QS(P1,0),                           pw2[0]=PKW(P1,0), pw2[1]=PKW(P1,2), pw2); \
    VRD(6); SBAR(); GAPA(C1=__builtin_amdgcn_mfma_f32_32x32x16_bf16(kf[5],qr[2],C1,0,0,0),   sacc=__builtin_fmaf(QS(P1,1),W81,sacc),   pw2[2]=PKW(P1,4), pw2[3]=PKW(P1,6), pw2); \
    VRD(3); SBAR(); GAPA(C0=__builtin_amdgcn_mfma_f32_32x32x16_bf16(kf[6],qr[3],C0,0,0,0),   sacc=__builtin_fmaf(QS(P1,2),W82,sacc),   pw3[0]=PKW(P1,8), pw3[1]=PKW(P1,10), pw3); \
    VRD(7); SBAR(); GAPA(C1=__builtin_amdgcn_mfma_f32_32x32x16_bf16(kf[7],qr[3],C1,0,0,0),   sacc=__builtin_fmaf(QS(P1,3),W83,sacc),   pw3[2]=PKW(P1,12),pw3[3]=PKW(P1,14), pw3); \
    l_reg=__builtin_fmaf(sacc,E32,l_reg); \
    if(GK){DMA_K((t)+3,sl_cur);} if(GV){DMA_V((t)+1,sl_next);} \
    CMASK(C0,C1,t); \
    { float a=MX3(C0[0],C0[1],C1[0]),b=MX3(C0[2],C0[3],C1[1]); a=MX3(a,C1[2],C1[3]); \
      _Pragma("unroll") for(int r=4;r<16;r+=4){a=MX3(a,C0[r],C0[r+1]);b=MX3(b,C0[r+2],C0[r+3]);a=MX3(a,C1[r],C1[r+1]);b=MX3(b,C1[r+2],C1[r+3]);} \
      float rm=__builtin_fmaxf(a,b); { auto rr=__builtin_amdgcn_permlane32_swap(__float_as_uint(rm),__float_as_uint(rm),false,false); rm=__builtin_fmaxf(__uint_as_float(rr[0]),__uint_as_float(rr[1])); } \
      resc=false; \
      if(__builtin_expect(__any(rm>(float)THRL),0)){ const float dl=__builtin_fmaxf(rm,0.f); nm-=dl; \
        _Pragma("unroll") for(int r=0;r<16;++r){C0[r]-=dl;C1[r]-=dl;} \
        const float f=__builtin_amdgcn_exp2f(-dl); l_reg*=f; if(hi==0)wsf[r32]=f; resc=true; } } \
    nm+=sl64; \
    SBAR(); \
    GAPB(o[0]=__builtin_amdgcn_mfma_f32_32x32x16_bf16(PAF(0),VFR(0),o[0],0,0,0), C0,0); \
    GAPB(o[1]=__builtin_amdgcn_mfma_f32_32x32x16_bf16(PAF(0),VFR(4),o[1],0,0,0), C0,4); \
    KRD(GL,0); GAPB(o[0]=__builtin_amdgcn_mfma_f32_32x32x16_bf16(PAF(1),VFR(1),o[0],0,0,0), C0,8); \
    KRD(GL,1); GAPB(o[1]=__builtin_amdgcn_mfma_f32_32x32x16_bf16(PAF(1),VFR(5),o[1],0,0,0), C0,12); \
    KRD(GL,2); GAPB(o[0]=__builtin_amdgcn_mfma_f32_32x32x16_bf16(PAF(2),VFR(2),o[0],0,0,0), C1,0); \
    KRD(GL,3); GAPB(o[1]=__builtin_amdgcn_mfma_f32_32x32x16_bf16(PAF(2),VFR(6),o[1],0,0,0), C1,4); \
    GAPB(o[0]=__builtin_amdgcn_mfma_f32_32x32x16_bf16(PAF(3),VFR(3),o[0],0,0,0), C1,8); \
    GAPB(o[1]=__builtin_amdgcn_mfma_f32_32x32x16_bf16(PAF(3),VFR(7),o[1],0,0,0), C1,12); \
    }while(0)
  int t=1;
  #undef CMASK
  #define CMASK(P0,P1,t) do{}while(0)
  for(;t+5<NT;t+=2){
    STEP(pB0,pB1,pA0,pA1,t,true,true,true);     WAIT_BAR(2); RESC(); ROT();
    STEP(pA0,pA1,pB0,pB1,t+1,true,true,true);   WAIT_BAR(2); RESC(); ROT();
  }
  #undef CMASK
  #define CMASK(P0,P1,t) do{int jb_=(t)-(NT-4); if(jb_>=0)cmask(P0,P1,jb_,qrel,hi);}while(0)
  #define ENDW(tt) do{ if((tt)+3<NT){WAIT_BAR(2);} else if((tt)+2<NT){WAIT_BAR(1);} else {WAIT_BAR(0);} }while(0)
  for(;t+1<NT;t+=2){
    STEP(pB0,pB1,pA0,pA1,t,(t+3<NT),(t+1<NT),(t+1<NT));       ENDW(t);   RESC(); ROT();
    STEP(pA0,pA1,pB0,pB1,t+1,(t+4<NT),(t+2<NT),(t+2<NT));     ENDW(t+1); RESC(); ROT();
  }
  STEP(pB0,pB1,pA0,pA1,NT-1,false,false,false); RESC();
  { const float sacc=__builtin_fmaf(QS(pB0,3),W83,__builtin_fmaf(QS(pB0,2),W82,__builtin_fmaf(QS(pB0,1),W81,QS(pB0,0)))), sacd=__builtin_fmaf(QS(pB1,3),W83,__builtin_fmaf(QS(pB1,2),W82,__builtin_fmaf(QS(pB1,1),W81,QS(pB1,0)))); l_reg+=sacc+sacd*E32;
    pw0=(u32x4){PKW(pB0,0),PKW(pB0,2),PKW(pB0,4),PKW(pB0,6)};pw1=(u32x4){PKW(pB0,8),PKW(pB0,10),PKW(pB0,12),PKW(pB0,14)};pw2=(u32x4){PKW(pB1,0),PKW(pB1,2),PKW(pB1,4),PKW(pB1,6)};pw3=(u32x4){PKW(pB1,8),PKW(pB1,10),PKW(pB1,12),PKW(pB1,14)};
    SBAR(); pv(o,vb0+sl_cur,PAF(0),PAF(1),PAF(2),PAF(3)); }
  #undef PKW
  #undef PAF
  #undef VFR
  #undef PIN
  #undef MX3
  #undef GAPA
  #undef QS
  #undef GAPB
  #undef EX
  #undef VRD
  #undef KRD
  #undef STEP
  #undef ENDW
  const int lane_e=mk_lane_id(),r32e=lane_e&31,hie=lane_e>>5;
  l_reg*=hie?E4:1.f;
  {auto rr=__builtin_amdgcn_permlane32_swap(__float_as_uint(l_reg),__float_as_uint(l_reg),false,false);l_reg=__uint_as_float(rr[0])+__uint_as_float(rr[1]);}
  if(hie==0)wsf[32+r32e]=l_reg;asm volatile("s_waitcnt lgkmcnt(0)":::"memory");
  float rli[16];
  #pragma unroll
  for(int r=0;r<16;++r)rli[r]=__builtin_amdgcn_rcpf(wsf[32+crow(r,hie)]);
  bf16*Ow=O+(rowbase+q0+wid*QBLK)*DM+h*D;
  { bf16*stg=(bf16*)(shm+LDS_OST)+wid*2048;
    #pragma unroll
    for(int r=0;r<16;++r){const int orow=crow(r,hie);
      #pragma unroll
      for(int d0=0;d0<2;++d0)stg[orow*64+d0*32+r32e]=__float2bfloat16(o[d0][r]*rli[r]);}
    asm volatile("s_waitcnt lgkmcnt(0)":::"memory");
    #pragma unroll
    for(int i=0;i<4;++i){const int row=i*8+(lane_e>>3),ch=lane_e&7; const u32x4 v=*(const u32x4*)(stg+row*64+ch*8); ATTN_STORE16(Ow+(long)row*DM+ch*8,v);} }
  asm volatile("s_waitcnt lgkmcnt(0)\n\ts_barrier":::"memory");
  #undef DMA_K
  #undef DMA_V
  #undef CMASK
  #undef SETNEG
  #undef UNI
  #undef RESC
  #undef ROT
}
constexpr int ATTN_LDS_BYTES=LDS_BYTES;
struct AttnTensors { const bf16* Q; const bf16* K; const bf16* V; bf16* O; };
struct AttnUnit { int bh; int qb; };
struct StaticOrder {
  int vcu;
  __device__ __forceinline__ explicit StaticOrder(int grid,int block):vcu((grid%8==0)?(block%8)*(grid/8)+block/8:block){}
  __device__ __forceinline__ bool next(int i,AttnUnit&u)const{ const int id=2*vcu+i; if(i>=2||id>=512)return false; const int s=vcu&15; u.bh=vcu>>4; u.qb=(i==0)?31-s:s; return true; }
  __device__ __forceinline__ void a_ready(const AttnUnit&)const{}
  __device__ __forceinline__ void done(const AttnUnit&)const{}
};
template<class Sched,int THRL=8> __device__ __forceinline__ void attn_phase(char*lds,const AttnTensors&T,const unsigned short*kmi,const Sched&S,const int wave_id){
  AttnUnit u;
  for(int i=0;S.next(i,u);++i){ S.a_ready(u); attn_unit<THRL>(u.bh/NHEAD,u.bh%NHEAD,u.qb,T.Q,T.K,T.V,T.O,kmi+(long)u.bh*2048,lds,wave_id); S.done(u); }
}
#undef SBAR
#undef WAIT_BAR
}

constexpr int NWAVES = 8;
constexpr int NB = 2, SEQ = 8192, D = 1024, M = NB * SEQ;
constexpr int NH = 8, HD = 64;
constexpr int MOBA_BLK = 256, NBLK = SEQ / MOBA_BLK;
constexpr int INC = 4608;
constexpr int ZC = 2560;
constexpr int ZQ = 0, ZK = 512, ZV = 1024, ZGU = 1536, ZGV = 2048;
constexpr int GC = 2048;
constexpr int PQC = 2048;
constexpr int NEXP = 16384;
constexpr float LN_EPS = 1e-5f;
constexpr float ALPHA = 1.189207115002721f;
constexpr float LOG2E = 1.4426950408889634f;
constexpr float C2 = 0.125f * LOG2E;

constexpr size_t MiB = 1u << 20;
constexpr size_t WS_CTL = 0, CTL_ZERO_BYTES = 1 * MiB;
constexpr size_t WS_MOD = 1 * MiB;
constexpr size_t WS_KMEAN = 1 * MiB + 64 * 1024;
constexpr size_t WS_WIN = 2 * MiB;
constexpr size_t WS_WA = 11 * MiB, WS_WG = 12 * MiB;
constexpr size_t WS_WOUT = 13 * MiB;
constexpr size_t WS_WPQ = 15 * MiB;
constexpr size_t WS_U16 = 20 * MiB, WS_V16 = 52 * MiB;
constexpr size_t WS_XN = 84 * MiB;
constexpr size_t WS_ZC = 116 * MiB;
constexpr size_t WS_TS = 180 * MiB;
constexpr size_t WS_IDX = 196 * MiB, WS_GW = 204 * MiB;
constexpr size_t WS_END = 212 * MiB;
constexpr int CW_BAR = 4096;

constexpr int RING_BYTES = 131072;
constexpr int LDSCTL_OFF = RING_BYTES, MISC_OFF = LDSCTL_OFF + 320;
constexpr int LDS_BYTES = 147456;

struct Frame {
    LAS unsigned char* lds;
    volatile LAS unsigned* MISC;
    gu32* ctl;
    int wave, G;
    const float *x, *c, *w_cond, *b_cond, *w_in, *w_attn_up, *w_gmlp_up, *w_out, *sgu_ln_g, *sgu_ln_b, *w_spatial, *b_spatial, *ln1_g, *ln1_b, *w_peer_q, *sub_keys, *peer_u, *peer_v, *ln2_g, *ln2_b;
    float* out;
    float *mod, *ts, *gw; int* idx; bf16* kmi;
    bf16 *win_t, *wa_t, *wg_t, *wout_t, *wpq_t, *u16, *v16, *xn, *zc, *pq, *gates;
};

__device__ __forceinline__ float wave_sum(float v) {
#pragma unroll
    for (int o = 1; o < 64; o <<= 1) v += __shfl_xor(v, o);
    return v;
}
__device__ __forceinline__ float bflo(unsigned w) { return __uint_as_float(w << 16); }
__device__ __forceinline__ float bfhi(unsigned w) { return __uint_as_float(w & 0xffff0000u); }
__device__ __forceinline__ float silu1(float x) { return x / (1.0f + __expf(-x)); }
__device__ __forceinline__ float gelu_erf(float x) { return 0.5f * x * (1.0f + erff(x * 0.70710678118654752f)); }

__device__ __forceinline__ void p0_transpose_item(const float* W, int K, int N, bf16* WT, LAS float* scr, int item, int lane) {
    const int nblk = N / 32, kb = item / nblk, nb = item % nblk, k0 = 64 * kb, n0 = 32 * nb;
#pragma unroll 8
    for (int i = 0; i < 32; ++i) { const int kk = 2 * i + (lane >> 5); scr[kk * 33 + (lane & 31)] = W[(size_t)(k0 + kk) * N + n0 + (lane & 31)]; }
    LDS_WAIT(); asm volatile("" ::: "memory");
    const int c = lane & 7;
#pragma unroll
    for (int j = 0; j < 4; ++j) { const int n = (lane >> 3) + 8 * j; const LAS float* s = scr + (8 * c) * 33 + n;
        v4u o; o.x = pk2(s[0 * 33], s[1 * 33]); o.y = pk2(s[2 * 33], s[3 * 33]); o.z = pk2(s[4 * 33], s[5 * 33]); o.w = pk2(s[6 * 33], s[7 * 33]);
        *(GAS v4u*)(WT + (size_t)(n0 + n) * K + k0 + 8 * c) = o; }
    LDS_WAIT(); asm volatile("" ::: "memory");
}

__device__ __forceinline__ void p0_prologue(Frame& F) {
    const int LANE = mk_lane_id(), TID = F.wave * 64 + LANE;
    {
        LAS float* part = (LAS float*)F.lds;
        for (int cg = blockIdx.x; cg < 256; cg += F.G) {
            if (TID < 384) {
                const int col = TID % 24, ks = TID / 24, j = 24 * cg + col;
                float a0 = 0.f, a1 = 0.f;
                for (int k = 64 * ks; k < 64 * ks + 64; ++k) {
                    const float wv = F.w_cond[(size_t)k * 6144 + j];
                    a0 += silu1(F.c[k]) * wv; a1 += silu1(F.c[1024 + k]) * wv;
                }
                part[(ks * 24 + col) * 2 + 0] = a0; part[(ks * 24 + col) * 2 + 1] = a1;
            }
            __syncthreads();
            if (TID < 48) {
                const int col = TID % 24, b = TID / 24; float s = F.b_cond[24 * cg + col];
                for (int ks = 0; ks < 16; ++ks) s += part[(ks * 24 + col) * 2 + b];
                F.mod[b * 6144 + 24 * cg + col] = s;
            }
            __syncthreads();
        }
    }
    {
        LAS float* scr = (LAS float*)(F.lds + F.wave * 16384);
        const int gw = blockIdx.x * NWAVES + F.wave, NGW = F.G * NWAVES;
        constexpr int I_IN = (D / 64) * (INC / 32), I_UP = (512 / 64) * (D / 32), I_OUT = (D / 64) * (D / 32), I_PQ = (D / 64) * (PQC / 32);
        constexpr int NITEMS = I_IN + 2 * I_UP + I_OUT + I_PQ;
        for (int it = gw; it < NITEMS; it += NGW) {
            int r = it;
            if (r < I_IN) { p0_transpose_item(F.w_in, D, INC, F.win_t, scr, r, LANE); continue; } r -= I_IN;
            if (r < I_UP) { p0_transpose_item(F.w_attn_up, 512, D, F.wa_t, scr, r, LANE); continue; } r -= I_UP;
            if (r < I_UP) { p0_transpose_item(F.w_gmlp_up, 512, D, F.wg_t, scr, r, LANE); continue; } r -= I_UP;
            if (r < I_OUT) { p0_transpose_item(F.w_out, D, D, F.wout_t, scr, r, LANE); continue; } r -= I_OUT;
            p0_transpose_item(F.w_peer_q, D, PQC, F.wpq_t, scr, r, LANE);
        }
    }
    {
        const size_t n8 = (size_t)NEXP * D / 8;
        const size_t gt = (size_t)blockIdx.x * (NWAVES * 64) + TID, NT = (size_t)F.G * (NWAVES * 64);
        for (size_t i = gt; i < 2 * n8; i += NT) {
            const bool second = i >= n8; const size_t j = second ? i - n8 : i;
            const f32x4* s = (const f32x4*)((second ? F.peer_v : F.peer_u) + j * 8);
            const f32x4 a = s[0], b = s[1];
            v4u o; o.x = pk2(a.x, a.y); o.y = pk2(a.z, a.w); o.z = pk2(b.x, b.y); o.w = pk2(b.z, b.w);
            *(v4u*)((second ? F.v16 : F.u16) + j * 8) = o;
        }
    }
}

__device__ __forceinline__ void p1_modulate(Frame& F) {
    const int LANE = mk_lane_id(), TID = F.wave * 64 + LANE;
    const int gw = blockIdx.x * NWAVES + F.wave, NGW = F.G * NWAVES;
    for (int m = gw; m < M; m += NGW) {
        const int b = m >> 13;
        const f32x4* xr = (const f32x4*)(F.x + (size_t)m * D) + LANE;
        f32x4 v[4]; float s = 0.f;
#pragma unroll
        for (int j = 0; j < 4; ++j) { v[j] = xr[64 * j]; s += (v[j].x + v[j].y) + (v[j].z + v[j].w); }
        const float mean = wave_sum(s) * (1.f / D); float s2 = 0.f;
#pragma unroll
        for (int j = 0; j < 4; ++j) { v[j] = v[j] - mean; s2 += (v[j].x * v[j].x + v[j].y * v[j].y) + (v[j].z * v[j].z + v[j].w * v[j].w); }
        const float rstd = 1.f / sqrtf(wave_sum(s2) * (1.f / D) + LN_EPS);
        unsigned long long* o8 = (unsigned long long*)(F.xn + (size_t)m * D) + LANE;
#pragma unroll
        for (int j = 0; j < 4; ++j) {
            const int col = 4 * LANE + 256 * j;
            const f32x4 sh = *(const f32x4*)(F.mod + b * 6144 + col), sc = *(const f32x4*)(F.mod + b * 6144 + 1024 + col);
            const f32x4 y = v[j] * rstd * (sc + 1.0f) + sh;
            o8[64 * j] = (unsigned long long)pk2(y.x, y.y) | ((unsigned long long)pk2(y.z, y.w) << 32);
        }
    }
}

__device__ __forceinline__ void p3_kmean(Frame& F) {
    const int LANE = mk_lane_id(), TID = F.wave * 64 + LANE;
    const int gt = blockIdx.x * (NWAVES * 64) + TID, NT = F.G * (NWAVES * 64);
    for (int i = gt; i < NB * NBLK * 512; i += NT) {
        const int col = i & 511, bb = i >> 9, b = bb >> 5, blk = bb & 31, h = col >> 6, d = col & 63;
        const bf16* p = F.zc + (size_t)bb * 256 * ZC + ZK + col;
        float s = 0.f;
        for (int r = 0; r < 256; ++r) s += bflo((unsigned)p[(size_t)r * ZC]);
        F.kmi[(size_t)(b * 8 + h) * 2048 + (d >> 3) * 256 + blk * 8 + (d & 7)] = (bf16)f2bf(s * (1.0f / 256.0f));
    }
}

__device__ __forceinline__ void p3_sgu(Frame& F) {
    const int LANE = mk_lane_id(), TID = F.wave * 64 + LANE;
    LAS float* vvn = (LAS float*)F.lds;
    LAS float* wsp = (LAS float*)(F.lds + 32768);
    const int t = TID >> 2, dq = TID & 3;
    for (int u = blockIdx.x; u < 1024; u += F.G) {
        const int chunk = u >> 3, g = u & 7; const size_t row0 = (size_t)chunk * 128;
        __syncthreads();
        {
            const bf16* p = F.zc + (row0 + t) * ZC + ZGV + g * 64 + dq * 16;
            const v4u w0 = *(const v4u*)p, w1 = *(const v4u*)(p + 8);
            float v[16];
            v[0] = bflo(w0.x); v[1] = bfhi(w0.x); v[2] = bflo(w0.y); v[3] = bfhi(w0.y); v[4] = bflo(w0.z); v[5] = bfhi(w0.z); v[6] = bflo(w0.w); v[7] = bfhi(w0.w);
            v[8] = bflo(w1.x); v[9] = bfhi(w1.x); v[10] = bflo(w1.y); v[11] = bfhi(w1.y); v[12] = bflo(w1.z); v[13] = bfhi(w1.z); v[14] = bflo(w1.w); v[15] = bfhi(w1.w);
            float s = 0.f;
#pragma unroll
            for (int k = 0; k < 16; ++k) s += v[k];
            s += __shfl_xor(s, 1); s += __shfl_xor(s, 2);
            const float mean = s * (1.0f / 64.0f); float q = 0.f;
#pragma unroll
            for (int k = 0; k < 16; ++k) { v[k] -= mean; q += v[k] * v[k]; }
            q += __shfl_xor(q, 1); q += __shfl_xor(q, 2);
            const float rstd = 1.f / sqrtf(q * (1.0f / 64.0f) + LN_EPS);
#pragma unroll
            for (int k = 0; k < 16; ++k) { const int d = dq * 16 + k; vvn[t * 64 + d] = v[k] * rstd * F.sgu_ln_g[g * 64 + d] + F.sgu_ln_b[g * 64 + d]; }
        }
        for (int i = TID; i < 16384; i += NWAVES * 64) wsp[(i >> 7) * 129 + (i & 127)] = F.w_spatial[(size_t)g * 16384 + i];
        __syncthreads();
        float acc[16];
#pragma unroll
        for (int k = 0; k < 16; ++k) acc[k] = 0.f;
        for (int s = 0; s <= t; ++s) {
            const float wv = wsp[t * 129 + s];
            const LAS f32x4* vp = (const LAS f32x4*)(vvn + s * 64 + dq * 16);
#pragma unroll
            for (int k4 = 0; k4 < 4; ++k4) { const f32x4 x = vp[k4]; acc[4 * k4 + 0] += wv * x.x; acc[4 * k4 + 1] += wv * x.y; acc[4 * k4 + 2] += wv * x.z; acc[4 * k4 + 3] += wv * x.w; }
        }
        const float bsp = F.b_spatial[g * 128 + t];
        bf16* up = F.zc + (row0 + t) * ZC + ZGU + g * 64 + dq * 16;
        const v4u u0 = *(const v4u*)up, u1 = *(const v4u*)(up + 8);
        v4u o0, o1;
        o0.x = pk2(bflo(u0.x) * (acc[0] + bsp), bfhi(u0.x) * (acc[1] + bsp)); o0.y = pk2(bflo(u0.y) * (acc[2] + bsp), bfhi(u0.y) * (acc[3] + bsp));
        o0.z = pk2(bflo(u0.z) * (acc[4] + bsp), bfhi(u0.z) * (acc[5] + bsp)); o0.w = pk2(bflo(u0.w) * (acc[6] + bsp), bfhi(u0.w) * (acc[7] + bsp));
        o1.x = pk2(bflo(u1.x) * (acc[8] + bsp), bfhi(u1.x) * (acc[9] + bsp)); o1.y = pk2(bflo(u1.y) * (acc[10] + bsp), bfhi(u1.y) * (acc[11] + bsp));
        o1.z = pk2(bflo(u1.z) * (acc[12] + bsp), bfhi(u1.z) * (acc[13] + bsp)); o1.w = pk2(bflo(u1.w) * (acc[14] + bsp), bfhi(u1.w) * (acc[15] + bsp));
        *(v4u*)up = o0; *(v4u*)(up + 8) = o1;
    }
    __syncthreads();
}

__device__ __forceinline__ void p7_ln(Frame& F) {
    const int LANE = mk_lane_id(), TID = F.wave * 64 + LANE;
    const int gw = blockIdx.x * NWAVES + F.wave, NGW = F.G * NWAVES;
    for (int m = gw; m < M; m += NGW) {
        const int b = m >> 13;
        f32x4* xr = (f32x4*)(F.out + (size_t)m * D) + LANE;
        f32x4 v[4]; float s = 0.f;
#pragma unroll
        for (int j = 0; j < 4; ++j) { v[j] = xr[64 * j]; s += (v[j].x + v[j].y) + (v[j].z + v[j].w); }
        float mean = wave_sum(s) * (1.f / D); float s2 = 0.f;
#pragma unroll
        for (int j = 0; j < 4; ++j) { v[j] = v[j] - mean; s2 += (v[j].x * v[j].x + v[j].y * v[j].y) + (v[j].z * v[j].z + v[j].w * v[j].w); }
        float rstd = 1.f / sqrtf(wave_sum(s2) * (1.f / D) + LN_EPS);
        s = 0.f;
#pragma unroll
        for (int j = 0; j < 4; ++j) {
            const int col = 4 * LANE + 256 * j;
            v[j] = v[j] * rstd * *(const f32x4*)(F.ln1_g + col) + *(const f32x4*)(F.ln1_b + col);
            xr[64 * j] = v[j];
            s += (v[j].x + v[j].y) + (v[j].z + v[j].w);
        }
        mean = wave_sum(s) * (1.f / D); s2 = 0.f;
#pragma unroll
        for (int j = 0; j < 4; ++j) { v[j] = v[j] - mean; s2 += (v[j].x * v[j].x + v[j].y * v[j].y) + (v[j].z * v[j].z + v[j].w * v[j].w); }
        rstd = 1.f / sqrtf(wave_sum(s2) * (1.f / D) + LN_EPS);
        unsigned long long* o8 = (unsigned long long*)(F.xn + (size_t)m * D) + LANE;
#pragma unroll
        for (int j = 0; j < 4; ++j) {
            const int col = 4 * LANE + 256 * j;
            const f32x4 sh = *(const f32x4*)(F.mod + b * 6144 + 3072 + col), sc = *(const f32x4*)(F.mod + b * 6144 + 4096 + col);
            const f32x4 y = v[j] * rstd * (sc + 1.0f) + sh;
            o8[64 * j] = (unsigned long long)pk2(y.x, y.y) | ((unsigned long long)pk2(y.z, y.w) << 32);
        }
    }
}

__device__ __forceinline__ void ins16(float (&L)[16], float v) {
#pragma unroll
    for (int i = 15; i >= 1; --i) L[i] = __builtin_amdgcn_fmed3f(L[i - 1], L[i], v);
    L[0] = fmaxf(L[0], v);
}
__device__ __forceinline__ void p9_topk_simple(Frame& F) {
    const int LANE = mk_lane_id(), TID = F.wave * 64 + LANE;
    LAS float* Kl = (LAS float*)F.lds;
    for (int u = blockIdx.x; u < 512; u += F.G) {
        const int hc = u & 15, tb = u >> 4;
        __syncthreads();
        for (int i = TID; i < 16384; i += NWAVES * 64) Kl[i] = F.sub_keys[(size_t)hc * 16384 + i];
        __syncthreads();
        const int t = tb * 512 + TID;
        const bf16* qp = F.pq + (size_t)t * PQC + hc * 128;
        float q[128];
#pragma unroll
        for (int i = 0; i < 16; ++i) { const v4u w = *(const v4u*)(qp + 8 * i);
            q[8 * i + 0] = bflo(w.x); q[8 * i + 1] = bfhi(w.x); q[8 * i + 2] = bflo(w.y); q[8 * i + 3] = bfhi(w.y);
            q[8 * i + 4] = bflo(w.z); q[8 * i + 5] = bfhi(w.z); q[8 * i + 6] = bflo(w.w); q[8 * i + 7] = bfhi(w.w); }
        float L[16];
#pragma unroll
        for (int i = 0; i < 16; ++i) L[i] = -INFINITY;
        for (int n = 0; n < 128; ++n) {
            const LAS f32x4* kp = (const LAS f32x4*)(Kl + n * 128);
            float d0 = 0.f, d1 = 0.f;
#pragma unroll
            for (int d4 = 0; d4 < 32; d4 += 2) { const f32x4 a = kp[d4], c = kp[d4 + 1];
                d0 += q[4 * d4] * a.x + q[4 * d4 + 1] * a.y + q[4 * d4 + 2] * a.z + q[4 * d4 + 3] * a.w;
                d1 += q[4 * d4 + 4] * c.x + q[4 * d4 + 5] * c.y + q[4 * d4 + 6] * c.z + q[4 * d4 + 7] * c.w; }
            const float dot = d0 + d1;
            ins16(L, __uint_as_float((__float_as_uint(dot) & ~127u) | (unsigned)n));
        }
        f32x4* o = (f32x4*)(F.ts + ((size_t)t * 16 + hc) * 16);
#pragma unroll
        for (int i = 0; i < 4; ++i) o[i] = (f32x4){L[4 * i], L[4 * i + 1], L[4 * i + 2], L[4 * i + 3]};
    }
    __syncthreads();
}

__device__ __forceinline__ void p9b_combine(Frame& F) {
    const int LANE = mk_lane_id(), TID = F.wave * 64 + LANE;
    const int gt = blockIdx.x * (NWAVES * 64) + TID, NT = F.G * (NWAVES * 64);
    for (int i = gt; i < M * 8; i += NT) {
        const int t = i >> 3, h = i & 7;
        const float* l0 = F.ts + ((size_t)t * 16 + 2 * h) * 16; const float* l1 = l0 + 16;
        float A[16], B[16];
#pragma unroll
        for (int k = 0; k < 4; ++k) { const f32x4 a = ((const f32x4*)l0)[k], b = ((const f32x4*)l1)[k];
            A[4 * k] = a.x; A[4 * k + 1] = a.y; A[4 * k + 2] = a.z; A[4 * k + 3] = a.w; B[4 * k] = b.x; B[4 * k + 1] = b.y; B[4 * k + 2] = b.z; B[4 * k + 3] = b.w; }
#pragma unroll
        for (int k = 0; k < 16; ++k) { A[k] = __uint_as_float(__float_as_uint(A[k]) & ~127u); B[k] = __uint_as_float(__float_as_uint(B[k]) & ~127u); }
        float R[16];
#pragma unroll
        for (int k = 0; k < 16; ++k) R[k] = -INFINITY;
#pragma unroll
        for (int a = 0; a < 16; ++a)
#pragma unroll
            for (int b = 0; b < 16; ++b)
                if ((a + 1) * (b + 1) <= 16) ins16(R, __uint_as_float((__float_as_uint(A[a] + B[b]) & ~255u) | (unsigned)(a * 16 + b)));
        float e[16]; float sum = 0.f; const float r0 = __uint_as_float(__float_as_uint(R[0]) & ~255u);
#pragma unroll
        for (int k = 0; k < 16; ++k) { e[k] = __expf(__uint_as_float(__float_as_uint(R[k]) & ~255u) - r0); sum += e[k]; }
        const float inv = 1.0f / sum;
#pragma unroll
        for (int k = 0; k < 16; ++k) {
            const unsigned bits = __float_as_uint(R[k]); const int a = (bits >> 4) & 15, b = bits & 15;
            const int i1 = (int)(__float_as_uint(l0[a]) & 127u), i2 = (int)(__float_as_uint(l1[b]) & 127u);
            F.idx[(size_t)t * 128 + h * 16 + k] = i1 * 128 + i2;
            F.gw[(size_t)t * 128 + h * 16 + k] = e[k] * inv;
        }
    }
}

__device__ __forceinline__ void p10_peer_simple(Frame& F) {
    const int LANE = mk_lane_id(), TID = F.wave * 64 + LANE;
    const int gw = blockIdx.x * NWAVES + F.wave, NGW = F.G * NWAVES;
    for (int m = gw; m < M; m += NGW) {
        const int b = m >> 13;
        float hrow[16];
        {   const bf16* hp = F.xn + (size_t)m * D + LANE * 8;
            const v4u w0 = *(const v4u*)hp, w1 = *(const v4u*)(hp + 512);
            hrow[0] = bflo(w0.x); hrow[1] = bfhi(w0.x); hrow[2] = bflo(w0.y); hrow[3] = bfhi(w0.y); hrow[4] = bflo(w0.z); hrow[5] = bfhi(w0.z); hrow[6] = bflo(w0.w); hrow[7] = bfhi(w0.w);
            hrow[8] = bflo(w1.x); hrow[9] = bfhi(w1.x); hrow[10] = bflo(w1.y); hrow[11] = bfhi(w1.y); hrow[12] = bflo(w1.z); hrow[13] = bfhi(w1.z); hrow[14] = bflo(w1.w); hrow[15] = bfhi(w1.w); }
        float acc[16];
#pragma unroll
        for (int k = 0; k < 16; ++k) acc[k] = 0.f;
        const int* ip = F.idx + (size_t)m * 128; const float* gp = F.gw + (size_t)m * 128;
#pragma unroll 4
        for (int k = 0; k < 128; ++k) {
            const int e = __builtin_amdgcn_readfirstlane(ip[k]); const float g = __uint_as_float(__builtin_amdgcn_readfirstlane(__float_as_uint(gp[k])));
            const bf16* up = F.u16 + (size_t)e * D + LANE * 8; const bf16* vp = F.v16 + (size_t)e * D + LANE * 8;
            const v4u u0 = *(const v4u*)up, u1 = *(const v4u*)(up + 512);
            const v4u v0 = *(const v4u*)vp, v1 = *(const v4u*)(vp + 512);
            float dsum = hrow[0] * bflo(u0.x) + hrow[1] * bfhi(u0.x) + hrow[2] * bflo(u0.y) + hrow[3] * bfhi(u0.y) + hrow[4] * bflo(u0.z) + hrow[5] * bfhi(u0.z) + hrow[6] * bflo(u0.w) + hrow[7] * bfhi(u0.w)
                       + hrow[8] * bflo(u1.x) + hrow[9] * bfhi(u1.x) + hrow[10] * bflo(u1.y) + hrow[11] * bfhi(u1.y) + hrow[12] * bflo(u1.z) + hrow[13] * bfhi(u1.z) + hrow[14] * bflo(u1.w) + hrow[15] * bfhi(u1.w);
            dsum = wave_sum(dsum);
            const float w = g * gelu_erf(dsum);
            acc[0] += w * bflo(v0.x); acc[1] += w * bfhi(v0.x); acc[2] += w * bflo(v0.y); acc[3] += w * bfhi(v0.y); acc[4] += w * bflo(v0.z); acc[5] += w * bfhi(v0.z); acc[6] += w * bflo(v0.w); acc[7] += w * bfhi(v0.w);
            acc[8] += w * bflo(v1.x); acc[9] += w * bfhi(v1.x); acc[10] += w * bflo(v1.y); acc[11] += w * bfhi(v1.y); acc[12] += w * bflo(v1.z); acc[13] += w * bfhi(v1.z); acc[14] += w * bflo(v1.w); acc[15] += w * bfhi(v1.w);
        }
        float* xr = F.out + (size_t)m * D; float y[16]; float s = 0.f;
#pragma unroll
        for (int hh = 0; hh < 2; ++hh) {
            const int col = hh * 512 + LANE * 8;
            const f32x4 xa = *(const f32x4*)(xr + col), xb = *(const f32x4*)(xr + col + 4);
            const f32x4 ga = *(const f32x4*)(F.mod + b * 6144 + 5120 + col), gb = *(const f32x4*)(F.mod + b * 6144 + 5120 + col + 4);
            y[8 * hh + 0] = ALPHA * xa.x + (1.f + ga.x) * acc[8 * hh + 0]; y[8 * hh + 1] = ALPHA * xa.y + (1.f + ga.y) * acc[8 * hh + 1];
            y[8 * hh + 2] = ALPHA * xa.z + (1.f + ga.z) * acc[8 * hh + 2]; y[8 * hh + 3] = ALPHA * xa.w + (1.f + ga.w) * acc[8 * hh + 3];
            y[8 * hh + 4] = ALPHA * xb.x + (1.f + gb.x) * acc[8 * hh + 4]; y[8 * hh + 5] = ALPHA * xb.y + (1.f + gb.y) * acc[8 * hh + 5];
            y[8 * hh + 6] = ALPHA * xb.z + (1.f + gb.z) * acc[8 * hh + 6]; y[8 * hh + 7] = ALPHA * xb.w + (1.f + gb.w) * acc[8 * hh + 7];
        }
#pragma unroll
        for (int k = 0; k < 16; ++k) s += y[k];
        const float mean = wave_sum(s) * (1.f / D); float s2 = 0.f;
#pragma unroll
        for (int k = 0; k < 16; ++k) { y[k] -= mean; s2 += y[k] * y[k]; }
        const float rstd = 1.f / sqrtf(wave_sum(s2) * (1.f / D) + LN_EPS);
#pragma unroll
        for (int hh = 0; hh < 2; ++hh) {
            const int col = hh * 512 + LANE * 8;
            const f32x4 g0 = *(const f32x4*)(F.ln2_g + col), g1 = *(const f32x4*)(F.ln2_g + col + 4), b0 = *(const f32x4*)(F.ln2_b + col), b1 = *(const f32x4*)(F.ln2_b + col + 4);
            f32x4 o0, o1;
            o0.x = y[8 * hh + 0] * rstd * g0.x + b0.x; o0.y = y[8 * hh + 1] * rstd * g0.y + b0.y; o0.z = y[8 * hh + 2] * rstd * g0.z + b0.z; o0.w = y[8 * hh + 3] * rstd * g0.w + b0.w;
            o1.x = y[8 * hh + 4] * rstd * g1.x + b1.x; o1.y = y[8 * hh + 5] * rstd * g1.y + b1.y; o1.z = y[8 * hh + 6] * rstd * g1.z + b1.z; o1.w = y[8 * hh + 7] * rstd * g1.w + b1.w;
            *(f32x4*)(xr + col) = o0; *(f32x4*)(xr + col + 4) = o1;
        }
    }
}

struct FnZ {
    bf16* zc; bf16* gates;
    __device__ __forceinline__ void operator()(int row, int col, pg8::f32x4 v0, pg8::f32x4 v1, int pn) const {
        if (pn < 2) { v0 = v0 * C2; v1 = v1 * C2; }
        else if (pn == 4 || pn == 5) { const float f = __builtin_amdgcn_exp2f(__builtin_amdgcn_exp2f(-(float)(((col - ZV) >> 6) + 1)) * LOG2E * (float)(row & 63)); v0 = v0 * f; v1 = v1 * f; }
        else if (pn >= 6 && pn < 10) { v0 = pg8::gelu4(v0); v1 = pg8::gelu4(v1); }
        else if (pn >= 10) { v0 = pg8::sigm4(v0); v1 = pg8::sigm4(v1); }
        bf16* dst = (pn < 10) ? zc + (size_t)row * ZC + col : gates + (size_t)row * GC + (col - ZC);
        *(pg8::u32x4*)dst = pg8::pack8(v0, v1);
    }
};
struct FnUpA {
    bf16* zc; const bf16* gates;
    __device__ __forceinline__ void operator()(int row, int col, pg8::f32x4 v0, pg8::f32x4 v1, int) const {
        pg8::f32x4 g0, g1; pg8::unpack8(*(const pg8::u32x4*)(gates + (size_t)row * GC + col), g0, g1);
        *(pg8::u32x4*)(zc + (size_t)row * ZC + 512 + col) = pg8::pack8(v0 * g0, v1 * g1);
    }
};
struct FnUpB {
    bf16* zc; const bf16* gates;
    __device__ __forceinline__ void operator()(int row, int col, pg8::f32x4 v0, pg8::f32x4 v1, int) const {
        pg8::f32x4 g0, g1, m0, m1; pg8::unpack8(*(const pg8::u32x4*)(gates + (size_t)row * GC + 1024 + col), g0, g1);
        bf16* p = zc + (size_t)row * ZC + 512 + col; pg8::unpack8(*(const pg8::u32x4*)p, m0, m1);
        *(pg8::u32x4*)p = pg8::pack8(m0 + v0 * g0, m1 + v1 * g1);
    }
};
struct FnV1 {
    const float* x; const float* mod; float* out;
    __device__ __forceinline__ void operator()(int row, int col, pg8::f32x4 v0, pg8::f32x4 v1, int) const {
        const int b = row >> 13; const float* gt = mod + b * 6144 + 2048 + col;
        const pg8::f32x4 x0 = *(const pg8::f32x4*)(x + (size_t)row * D + col), x1 = *(const pg8::f32x4*)(x + (size_t)row * D + col + 4);
        const pg8::f32x4 t0 = *(const pg8::f32x4*)gt, t1 = *(const pg8::f32x4*)(gt + 4);
        *(pg8::f32x4*)(out + (size_t)row * D + col) = x0 * ALPHA + (t0 + 1.0f) * v0;
        *(pg8::f32x4*)(out + (size_t)row * D + col + 4) = x1 * ALPHA + (t1 + 1.0f) * v1;
    }
};
struct FnPlain {
    bf16* o; int ldc;
    __device__ __forceinline__ void operator()(int row, int col, pg8::f32x4 v0, pg8::f32x4 v1, int) const { *(pg8::u32x4*)(o + (size_t)row * ldc + col) = pg8::pack8(v0, v1); }
};

constexpr int NPH = 12;
#ifndef MK_PER_PHASE
#define MK_PER_PHASE 0
#endif
struct Args { const float* in[20]; float* out; unsigned char* ws; int ph_lo, ph_hi; };
__global__ void __launch_bounds__(NWAVES * 64, 2) mk_fwd(Args args) {
    extern __shared__ __attribute__((aligned(16))) unsigned char lds[];
    Frame F;
    F.lds = (LAS unsigned char*)lds;
    F.MISC = (volatile LAS unsigned*)(F.lds + MISC_OFF);
    F.wave = __builtin_amdgcn_readfirstlane((int)threadIdx.x >> 6); F.G = gridDim.x;
    unsigned char* ws = args.ws;
    F.ctl = (gu32*)(ws + WS_CTL);
    F.x = args.in[0]; F.c = args.in[1]; F.w_cond = args.in[2]; F.b_cond = args.in[3]; F.w_in = args.in[4]; F.w_attn_up = args.in[5]; F.w_gmlp_up = args.in[6]; F.w_out = args.in[7];
    F.sgu_ln_g = args.in[8]; F.sgu_ln_b = args.in[9]; F.w_spatial = args.in[10]; F.b_spatial = args.in[11]; F.ln1_g = args.in[12]; F.ln1_b = args.in[13]; F.w_peer_q = args.in[14];
    F.sub_keys = args.in[15]; F.peer_u = args.in[16]; F.peer_v = args.in[17]; F.ln2_g = args.in[18]; F.ln2_b = args.in[19];
    F.out = args.out;
    F.mod = (float*)(ws + WS_MOD); F.kmi = (bf16*)(ws + WS_KMEAN); F.ts = (float*)(ws + WS_TS); F.gw = (float*)(ws + WS_GW); F.idx = (int*)(ws + WS_IDX);
    F.win_t = (bf16*)(ws + WS_WIN); F.wa_t = (bf16*)(ws + WS_WA); F.wg_t = (bf16*)(ws + WS_WG); F.wout_t = (bf16*)(ws + WS_WOUT); F.wpq_t = (bf16*)(ws + WS_WPQ);
    F.u16 = (bf16*)(ws + WS_U16); F.v16 = (bf16*)(ws + WS_V16); F.xn = (bf16*)(ws + WS_XN); F.zc = (bf16*)(ws + WS_ZC); F.pq = (bf16*)(ws + WS_ZC); F.gates = (bf16*)args.out;
    for (int u = threadIdx.x; u < (LDS_BYTES - LDSCTL_OFF) / 4; u += NWAVES * 64) ((LAS unsigned*)(F.lds + LDSCTL_OFF))[u] = 0u;
    __syncthreads();
    const int lo = args.ph_lo, hi = args.ph_hi;
    XcdBarrier bar; bar.bar = (unsigned*)(F.ctl + CW_BAR); bar.x = 0; bar.st = nullptr; bar.wave = F.wave;
    if (hi - lo > 1) bar = xcd_barrier_post((unsigned*)(F.ctl + CW_BAR), F.MISC + 8, F.wave);
#define IN(k) (lo <= (k) && (k) < hi)
#define SEAM(k) do { if (IN(k) && IN((k) + 1)) xcd_barrier(bar); } while (0)

    if (IN(0)) { p0_prologue(F); SEAM(0); }
    if (IN(1)) { p1_modulate(F); SEAM(1); }
    if (IN(2)) {
        pg8::Gemm g{F.xn, F.win_t, M, INC, D, D, D}; pg8::StaticOrder S; S.init(M, INC, F.G, (int)blockIdx.x);
        pg8::EpiFn<FnZ> E{FnZ{F.zc, F.gates}};
        pg8::gemm_phase<pg8::EpiFn<FnZ>, pg8::StaticOrder, true, true>(F.lds, g, S, E, F.wave);
        SEAM(2);
    }
    if (IN(3)) { p3_kmean(F); p3_sgu(F); SEAM(3); }
    if (IN(4)) {
        const attn_body::AttnTensors AT{(const attn_body::bf16*)(F.zc + ZQ), (const attn_body::bf16*)(F.zc + ZK), (const attn_body::bf16*)(F.zc + ZV), (attn_body::bf16*)(F.zc + ZQ)};
        const attn_body::StaticOrder S((int)F.G, (int)blockIdx.x);
        attn_body::attn_phase<attn_body::StaticOrder>((char*)lds, AT, (const unsigned short*)F.kmi, S, F.wave);
        SEAM(4);
    }
    if (IN(5)) {
        { pg8::Gemm g{F.zc + ZQ, F.wa_t, M, D, 512, ZC, 512}; pg8::StaticOrder S; S.init(M, D, F.G, (int)blockIdx.x);
          pg8::EpiFn<FnUpA> E{FnUpA{F.zc, F.gates}};
          pg8::gemm_phase<pg8::EpiFn<FnUpA>, pg8::StaticOrder, true, true>(F.lds, g, S, E, F.wave); }
        VM_WAIT(); __syncthreads();
        { pg8::Gemm g{F.zc + ZGU, F.wg_t, M, D, 512, ZC, 512}; pg8::StaticOrder S; S.init(M, D, F.G, (int)blockIdx.x);
          pg8::EpiFn<FnUpB> E{FnUpB{F.zc, F.gates}};
          pg8::gemm_phase<pg8::EpiFn<FnUpB>, pg8::StaticOrder, true, true>(F.lds, g, S, E, F.wave); }
        SEAM(5);
    }
    if (IN(6)) {
        pg8::Gemm g{F.zc + 512, F.wout_t, M, D, D, ZC, D}; pg8::StaticOrder S; S.init(M, D, F.G, (int)blockIdx.x);
        pg8::EpiFn<FnV1> E{FnV1{F.x, F.mod, F.out}};
        pg8::gemm_phase<pg8::EpiFn<FnV1>, pg8::StaticOrder, true, true>(F.lds, g, S, E, F.wave);
        SEAM(6);
    }
    if (IN(7)) { p7_ln(F); SEAM(7); }
    if (IN(8)) {
        pg8::Gemm g{F.xn, F.wpq_t, M, PQC, D, D, D}; pg8::StaticOrder S; S.init(M, PQC, F.G, (int)blockIdx.x);
        pg8::EpiFn<FnPlain> E{FnPlain{F.pq, PQC}};
        pg8::gemm_phase<pg8::EpiFn<FnPlain>, pg8::StaticOrder, true, true>(F.lds, g, S, E, F.wave);
        SEAM(8);
    }
    if (IN(9)) { p9_topk_simple(F); SEAM(9); }
    if (IN(10)) { p9b_combine(F); SEAM(10); }
    if (IN(11)) { p10_peer_simple(F); }
#undef IN
#undef SEAM
}

extern "C" void kernel_launch(void* const* d_in, const int* in_sizes, int n_in, void* d_out, int out_size, void* d_ws, size_t ws_size, hipStream_t stream) {
    static int grid = 0;
    if (grid == 0) {
        if (n_in != 20 || in_sizes[0] != M * D || out_size != M * D || ws_size < WS_END) { fprintf(stderr, "kernel_launch: unexpected shapes (n_in %d, in0 %d, out %d, ws %zu); nothing launched\n", n_in, n_in > 0 ? in_sizes[0] : -1, out_size, ws_size); grid = -1; return; }
        int dev = 0, cus = 0;
        if (hipGetDevice(&dev) != hipSuccess || hipDeviceGetAttribute(&cus, hipDeviceAttributeMultiprocessorCount, dev) != hipSuccess) { grid = -1; return; }
        if (hipFuncSetAttribute((const void*)mk_fwd, hipFuncAttributeMaxDynamicSharedMemorySize, LDS_BYTES) != hipSuccess) { fprintf(stderr, "kernel_launch: hipFuncSetAttribute failed\n"); grid = -1; return; }
        (void)hipGetLastError();
        grid = cus < 256 ? cus : 256;
    }
    if (grid < 0) return;
    if (hipMemsetAsync((char*)d_ws + WS_CTL, 0, CTL_ZERO_BYTES, stream) != hipSuccess) return;
    Args a{};
    for (int i = 0; i < 20; ++i) a.in[i] = (const float*)d_in[i];
    a.out = (float*)d_out; a.ws = (unsigned char*)d_ws;
#if MK_PER_PHASE
    for (int p = 0; p < NPH; ++p) { a.ph_lo = p; a.ph_hi = p + 1; hipLaunchKernelGGL(mk_fwd, dim3(grid), dim3(NWAVES * 64), LDS_BYTES, stream, a); }
#else
    a.ph_lo = 0; a.ph_hi = NPH; hipLaunchKernelGGL(mk_fwd, dim3(grid), dim3(NWAVES * 64), LDS_BYTES, stream, a);
#endif
}
```

```cpp
#include <hip/hip_runtime.h>
#include <cstdio>
#include <cstdint>
#include <cmath>
__device__ __forceinline__ int mk_lane_id() { int l; asm volatile("v_mbcnt_lo_u32_b32 %0, -1, 0\n\tv_mbcnt_hi_u32_b32 %0, -1, %0" : "=v"(l)); return l; }
namespace pg8 {
#define PG8_LAS __attribute__((address_space(3)))
typedef unsigned short bf16_t;
typedef short bf16x8 __attribute__((ext_vector_type(8)));
typedef float f32x4 __attribute__((ext_vector_type(4)));
typedef unsigned u32x4 __attribute__((ext_vector_type(4)));
constexpr int BM = 256, BK = 64, HALF = 128, HTB = HALF * BK * 2  , STAGE_BYTES = 8 * HTB, NXCD = 8, WGM = 8;

__host__ __device__ __forceinline__ int lds_byte(int r, int c) { const int st = (r >> 4) * 2 + (c >> 5), rr = r & 15, cc = c & 31, ob = rr * 64 + cc * 2; return st * 1024 + (ob ^ (((ob >> 9) & 1) << 5)); }
__host__ __device__ __forceinline__ void stage_rc(int b, int& R, int& C) { const int st = b / 1024, sb = b % 1024, swz = sb ^ (((sb >> 9) & 1) << 5); R = (st >> 1) * 16 + swz / 64; C = (st & 1) * 32 + (swz % 64) / 2; }
__host__ __device__ __forceinline__ int perm32(int rho) { const int n = rho >> 4, i = rho & 15; return 8 * (i >> 2) + 4 * n + (i & 3); }

struct Unit { int pm, pn; };
struct Gemm { const bf16_t* A; const bf16_t* Bt; int M, N, K, lda, ldb; };

struct StaticOrder {
    int nM, nN, nwg, G, c;
    __host__ __device__ void init(int M, int N, int G_, int c_) { nM = M / BM; nN = N / BM; nwg = nM * nN; G = G_; c = c_; }
    __host__ __device__ bool next(int i, Unit& u) const {
        const long L = (long)i * G + c; if (L >= nwg) return false;
        int wgid = (int)L; { const int q = nwg / NXCD, r = nwg % NXCD, xcd = wgid % NXCD, off = wgid / NXCD; wgid = (xcd < r ? xcd * (q + 1) : r * (q + 1) + (xcd - r) * q) + off; }
        const int nig = WGM * nN, gid = wgid / nig, fm = gid * WGM, gsz = (nM - fm) < WGM ? (nM - fm) : WGM;
        u.pm = fm + ((wgid % nig) % gsz); u.pn = (wgid % nig) / gsz; return true;
    }
    __device__ __forceinline__ void a_ready(const Unit&) const {}
    __device__ __forceinline__ void done(const Unit&) const {}
};

__device__ __forceinline__ unsigned cvt_pk_bf16(float lo, float hi) { unsigned r; asm volatile("v_cvt_pk_bf16_f32 %0, %1, %2" : "=v"(r) : "v"(lo), "v"(hi)); return r; }
typedef float f32x2 __attribute__((ext_vector_type(2)));
__device__ __forceinline__ f32x2 gelu_pk(f32x2 v) {
    const f32x2 av = __builtin_elementwise_abs(v), d = av * 0.2316418882f + 1.0f;
    f32x2 t; t.x = __builtin_amdgcn_rcpf(d.x); t.y = __builtin_amdgcn_rcpf(d.y);
    f32x2 q = t * 0.5307027145f + (-0.7265760135f); q = q * t + 0.7107068705f; q = q * t + (-0.142248368f); q = q * t + 0.127414796f; q = q * t;
    const f32x2 s = (v * v) * (-0.72134752044f);
    f32x2 e; e.x = __builtin_amdgcn_exp2f(s.x); e.y = __builtin_amdgcn_exp2f(s.y);
    const f32x2 m = v * (q * e), r = v - m;
    f32x2 o; o.x = v.x < 0.f ? m.x : r.x; o.y = v.y < 0.f ? m.y : r.y; return o;
}

template <class Fn> struct EpiFn {
    static constexpr bool PERM = true, AFTER_DRAIN = false; Fn fn;
    __device__ __forceinline__ void operator()(const f32x4 (&acc)[2][2][4][2], const Unit& u, int wr, int wc, int fr, int fq) const {
        const int row0 = u.pm * BM + wr * 64 + fr, col0 = u.pn * BM + wc * 32 + 8 * fq;
#pragma unroll
        for (int ai = 0; ai < 2; ++ai)
#pragma unroll
            for (int m = 0; m < 4; ++m)
#pragma unroll
                for (int bj = 0; bj < 2; ++bj) fn(row0 + ai * HALF + m * 16, col0 + bj * HALF, acc[ai][bj][m][0], acc[ai][bj][m][1], u.pn);
    }
};
__device__ __forceinline__ u32x4 pack8(f32x4 v0, f32x4 v1) { u32x4 w; w.x = cvt_pk_bf16(v0[0], v0[1]); w.y = cvt_pk_bf16(v0[2], v0[3]); w.z = cvt_pk_bf16(v1[0], v1[1]); w.w = cvt_pk_bf16(v1[2], v1[3]); return w; }
__device__ __forceinline__ f32x4 gelu4(f32x4 v) { f32x2 a = gelu_pk((f32x2){v[0], v[1]}), b = gelu_pk((f32x2){v[2], v[3]}); return (f32x4){a.x, a.y, b.x, b.y}; }
__device__ __forceinline__ float sigm1(float x) { return __builtin_amdgcn_rcpf(1.0f + __builtin_amdgcn_exp2f(-1.4426950408889634f * x)); }
__device__ __forceinline__ f32x4 sigm4(f32x4 v) { return (f32x4){sigm1(v[0]), sigm1(v[1]), sigm1(v[2]), sigm1(v[3])}; }
__device__ __forceinline__ void unpack8(u32x4 w, f32x4& a, f32x4& b) {
    a = (f32x4){__uint_as_float(w.x << 16), __uint_as_float(w.x & 0xffff0000u), __uint_as_float(w.y << 16), __uint_as_float(w.y & 0xffff0000u)};
    b = (f32x4){__uint_as_float(w.z << 16), __uint_as_float(w.z & 0xffff0000u), __uint_as_float(w.w << 16), __uint_as_float(w.w & 0xffff0000u)};
}
template <class Epi, class Sched, bool ALIGN_EPI = false, bool SP2 = false>
__device__ __forceinline__ void gemm_phase(PG8_LAS unsigned char* lds, const Gemm g, const Sched& S, const Epi& E, const int wave_id  ) {
    const int wid = wave_id, lane = mk_lane_id(), tid = wid * 64 + lane, wr = wid >> 2, wc = wid & 3, fr = lane & 15, fq = lane >> 4;
    const int K = g.K, nt = K / BK;
    unsigned voffA[2], voffB[2];
#pragma unroll
    for (int i = 0; i < 2; ++i) { int R, C; stage_rc(tid * 16 + i * 8192, R, C); const int Rb = Epi::PERM ? ((R & ~31) + perm32(R & 31)) : R;
        voffA[i] = (unsigned)(R * g.lda + C) * 2u; voffB[i] = (unsigned)(Rb * g.ldb + C) * 2u; }
    const size_t kstep = (size_t)(BK * 2);
    const size_t hstepA = (size_t)HALF * g.lda * 2, hstepB = (size_t)HALF * g.ldb * 2;
    const size_t tstepA = 2 * hstepA, tstepB = 2 * hstepB;
    const unsigned ldsw = (unsigned)wid * 1024u;
    const int aoff = lds_byte(wr * 64 + fr, fq * 8), boff = lds_byte(wc * 32 + fr, fq * 8);
#define PG8_SA(b, h) (((b) * 2 + (h)) * HTB)
#define PG8_SB(b, h) ((4 + (b) * 2 + (h)) * HTB)
#define PG8_STAGE(bufoff, gbase, voff) do { _Pragma("unroll") for (int _i = 0; _i < 2; ++_i) \
        __builtin_amdgcn_global_load_lds((const unsigned*)((const char*)(gbase) + (voff)[_i]), (PG8_LAS unsigned*)(lds + (bufoff) + ldsw + _i * 8192), 16, 0, 0); } while (0)
#define PG8_LDA(dst, b, h) do { _Pragma("unroll") for (int m = 0; m < 4; ++m) _Pragma("unroll") for (int k = 0; k < 2; ++k) dst[m][k] = *(const PG8_LAS bf16x8*)(lds + PG8_SA(b, h) + aoff + m * 2048 + k * 1024); } while (0)
#define PG8_LDB(dst, b, h) do { _Pragma("unroll") for (int n = 0; n < 2; ++n) _Pragma("unroll") for (int k = 0; k < 2; ++k) dst[n][k] = *(const PG8_LAS bf16x8*)(lds + PG8_SB(b, h) + boff + n * 2048 + k * 1024); } while (0)
#define PG8_MMA(ai, bj, At, Bt) do { __builtin_amdgcn_s_setprio(1); _Pragma("unroll") for (int m = 0; m < 4; ++m) _Pragma("unroll") for (int n = 0; n < 2; ++n) _Pragma("unroll") for (int k = 0; k < 2; ++k) \
        acc[ai][bj][m][n] = __builtin_amdgcn_mfma_f32_16x16x32_bf16(Bt[n][k], At[m][k], acc[ai][bj][m][n], 0, 0, 0); __builtin_amdgcn_s_setprio(0); } while (0)
#define PG8_WAIT_V(n) asm volatile("s_waitcnt vmcnt(" #n ")" ::: "memory")
#define PG8_WAIT_L(n) asm volatile("s_waitcnt lgkmcnt(" #n ")" ::: "memory")
#define PG8_BAR __builtin_amdgcn_s_barrier()
#define PG8_SCHED __builtin_amdgcn_sched_barrier(0)
    Unit cur, nxt; int ui = 0;
    if (!S.next(0, cur)) return;
    f32x4 acc[2][2][4][2];
#pragma unroll
    for (int a = 0; a < 2; ++a)
#pragma unroll
        for (int b = 0; b < 2; ++b)
#pragma unroll
            for (int m = 0; m < 4; ++m)
#pragma unroll
                for (int n = 0; n < 2; ++n) acc[a][b][m][n] = (f32x4){0.f, 0.f, 0.f, 0.f};
    bf16x8 At[4][2], B0[2][2], B1[2][2];
    const char* cA = (const char*)g.A + (size_t)cur.pm * tstepA; const char* cB = (const char*)g.Bt + (size_t)cur.pn * tstepB;
    S.a_ready(cur);
    if constexpr (SP2) {
        PG8_STAGE(PG8_SB(0, 0), cB, voffB); PG8_STAGE(PG8_SB(0, 1), cB + hstepB, voffB); PG8_STAGE(PG8_SA(0, 0), cA, voffA); PG8_STAGE(PG8_SA(0, 1), cA + hstepA, voffA);
        if (wr == 1) PG8_BAR;
        PG8_WAIT_V(2); PG8_BAR;
        PG8_STAGE(PG8_SB(1, 0), cB + kstep, voffB); PG8_STAGE(PG8_SA(1, 0), cA + kstep, voffA); PG8_STAGE(PG8_SB(1, 1), cB + hstepB + kstep, voffB);
        PG8_WAIT_V(6); PG8_BAR;
    } else {
        PG8_STAGE(PG8_SB(0, 0), cB, voffB); PG8_STAGE(PG8_SA(0, 0), cA, voffA); PG8_STAGE(PG8_SB(0, 1), cB + hstepB, voffB); PG8_STAGE(PG8_SA(0, 1), cA + hstepA, voffA);
        if (wr == 1) PG8_BAR;
        PG8_WAIT_V(4); PG8_BAR;
        PG8_STAGE(PG8_SB(1, 0), cB + kstep, voffB); PG8_STAGE(PG8_SA(1, 0), cA + kstep, voffA); PG8_STAGE(PG8_SB(1, 1), cB + hstepB + kstep, voffB);
        PG8_WAIT_V(6); PG8_BAR;
    }
    for (;;) {
        const bool has_next = S.next(ui + 1, nxt);
        const char* nA = has_next ? (const char*)g.A + (size_t)nxt.pm * tstepA : cA; const char* nB = has_next ? (const char*)g.Bt + (size_t)nxt.pn * tstepB : cB;
        for (int t = 0; t < nt; t += 2) {
            const bool last = (t == nt - 2);
            const char* a1 = cA + (size_t)(t + 1) * kstep;
            const char* a2 = last ? nA : cA + (size_t)(t + 2) * kstep; const char* b2 = last ? nB : cB + (size_t)(t + 2) * kstep;
            const char* a3 = a2 + kstep; const char* b3 = b2 + kstep;
            if (last && has_next) S.a_ready(nxt);
            if constexpr (SP2) {
            PG8_LDB(B0, 0, 0); PG8_LDB(B1, 0, 1); PG8_SCHED; PG8_LDA(At, 0, 0); PG8_STAGE(PG8_SA(1, 1), a1 + hstepA, voffA);
            PG8_WAIT_V(8); PG8_WAIT_L(0); PG8_BAR; PG8_MMA(0, 0, At, B0); PG8_MMA(0, 1, At, B1); PG8_BAR; PG8_SCHED;
            PG8_LDA(At, 0, 1); PG8_STAGE(PG8_SB(0, 0), b2, voffB); PG8_STAGE(PG8_SB(0, 1), b2 + hstepB, voffB); PG8_STAGE(PG8_SA(0, 0), a2, voffA);
            PG8_WAIT_V(8); PG8_WAIT_L(0); PG8_BAR; PG8_MMA(1, 0, At, B0); PG8_MMA(1, 1, At, B1); PG8_BAR; PG8_SCHED;
            PG8_LDB(B0, 1, 0); PG8_LDB(B1, 1, 1); PG8_SCHED; PG8_LDA(At, 1, 0); PG8_STAGE(PG8_SA(0, 1), a2 + hstepA, voffA);
            PG8_WAIT_V(8); PG8_WAIT_L(0); PG8_BAR; PG8_MMA(0, 0, At, B0); PG8_MMA(0, 1, At, B1); PG8_BAR; PG8_SCHED;
            PG8_LDA(At, 1, 1); PG8_STAGE(PG8_SB(1, 0), b3, voffB); PG8_STAGE(PG8_SB(1, 1), b3 + hstepB, voffB); PG8_STAGE(PG8_SA(1, 0), a3, voffA);
            PG8_WAIT_V(8); PG8_WAIT_L(0); PG8_BAR; PG8_MMA(1, 0, At, B0); PG8_MMA(1, 1, At, B1); PG8_BAR; PG8_SCHED;
            } else {
            PG8_LDB(B0, 0, 0); PG8_SCHED; PG8_LDA(At, 0, 0); PG8_STAGE(PG8_SA(1, 1), a1 + hstepA, voffA);
            PG8_WAIT_L(8); PG8_BAR; PG8_WAIT_L(0); PG8_MMA(0, 0, At, B0); PG8_BAR; PG8_SCHED;
            PG8_LDB(B1, 0, 1); PG8_STAGE(PG8_SB(0, 0), b2, voffB);
            PG8_BAR; PG8_WAIT_L(0); PG8_MMA(0, 1, At, B1); PG8_BAR;
            PG8_LDA(At, 0, 1); PG8_STAGE(PG8_SA(0, 0), a2, voffA);
            PG8_BAR; PG8_WAIT_L(0); PG8_MMA(1, 0, At, B0); PG8_BAR; PG8_SCHED;
            PG8_STAGE(PG8_SB(0, 1), b2 + hstepB, voffB);
            PG8_WAIT_V(6); PG8_BAR; PG8_MMA(1, 1, At, B1); PG8_BAR;
            PG8_LDB(B0, 1, 0); PG8_SCHED; PG8_LDA(At, 1, 0); PG8_STAGE(PG8_SA(0, 1), a2 + hstepA, voffA);
            PG8_WAIT_L(8); PG8_BAR; PG8_WAIT_L(0); PG8_MMA(0, 0, At, B0); PG8_BAR; PG8_SCHED;
            PG8_LDB(B1, 1, 1); PG8_STAGE(PG8_SB(1, 0), b3, voffB);
            PG8_BAR; PG8_WAIT_L(0); PG8_MMA(0, 1, At, B1); PG8_BAR;
            PG8_LDA(At, 1, 1); PG8_STAGE(PG8_SA(1, 0), a3, voffA);
            PG8_BAR; PG8_WAIT_L(0); PG8_MMA(1, 0, At, B0); PG8_BAR; PG8_SCHED;
            PG8_STAGE(PG8_SB(1, 1), b3 + hstepB, voffB);
            PG8_WAIT_V(6); PG8_BAR; PG8_MMA(1, 1, At, B1); PG8_BAR;
            }
        }
        if constexpr (ALIGN_EPI) { if (wr == 0) PG8_BAR; }
        if constexpr (!Epi::AFTER_DRAIN) { E(acc, cur, wr, wc, fr, fq); S.done(cur); }
        if (!has_next) break;
#pragma unroll
        for (int a = 0; a < 2; ++a)
#pragma unroll
            for (int b = 0; b < 2; ++b)
#pragma unroll
                for (int m = 0; m < 4; ++m)
#pragma unroll
                    for (int n = 0; n < 2; ++n) acc[a][b][m][n] = (f32x4){0.f, 0.f, 0.f, 0.f};
        cur = nxt; cA = nA; cB = nB; ++ui;
        if constexpr (ALIGN_EPI) { if (wr == 1) PG8_BAR; }
    }
    PG8_WAIT_V(0);
    if constexpr (!ALIGN_EPI) { if (wr == 0) PG8_BAR; }
    PG8_BAR;
    if constexpr (Epi::AFTER_DRAIN) { E.fused(acc, cur, wr, wc, fr, fq, lds, wid, lane); S.done(cur); }
#undef PG8_SA
#undef PG8_SB
#undef PG8_STAGE
#undef PG8_LDA
#undef PG8_LDB
#undef PG8_MMA
#undef PG8_WAIT_V
#undef PG8_WAIT_L
#undef PG8_BAR
#undef PG8_SCHED
}
}
#define GAS __attribute__((address_space(1)))
#define LAS __attribute__((address_space(3)))
typedef unsigned short bf16;
typedef unsigned v4u __attribute__((ext_vector_type(4)));
typedef float f32x4 __attribute__((ext_vector_type(4)));
typedef short bf16x8 __attribute__((ext_vector_type(8)));
typedef GAS unsigned gu32;
typedef GAS unsigned long long gu64;
#define RLX_AGENT __ATOMIC_RELAXED, __HIP_MEMORY_SCOPE_AGENT
#define LDS_WAIT() asm volatile("s_waitcnt lgkmcnt(0)" ::: "memory")
#define VM_WAIT() asm volatile("s_waitcnt vmcnt(0)" ::: "memory")
__device__ __forceinline__ unsigned long long rt() { return __builtin_amdgcn_s_memrealtime(); }
__device__ __forceinline__ unsigned f2bf(float f) { unsigned u = __builtin_bit_cast(unsigned, f); return (u + 0x7fffu + ((u >> 16) & 1u)) >> 16; }
__device__ __forceinline__ unsigned pk2(float lo, float hi) { return f2bf(lo) | (f2bf(hi) << 16); }

#define XB_TMO      128
#define XB_XCNT(j)  (256  + 64 * (j))
#define XB_XSUB(j)  (1280 + 64 * (j))
#define XB_XGEN(j)  (2304 + 64 * (j))
#define XB_TOP      3328
#define XB_TOPGEN   3392
#define XCD_BAR_WORDS 3456
#define XB_SPIN_CAP (1u << 18)

__device__ __forceinline__ unsigned xb_ld(unsigned* p)              { return __hip_atomic_load(p, __ATOMIC_RELAXED, __HIP_MEMORY_SCOPE_AGENT); }
__device__ __forceinline__ unsigned xb_add(unsigned* p, unsigned v) { return __hip_atomic_fetch_add(p, v, __ATOMIC_RELAXED, __HIP_MEMORY_SCOPE_AGENT); }
__device__ __forceinline__ unsigned xb_xcc_id() { return (unsigned)__builtin_amdgcn_s_getreg((3 << 11) | 20) & 0xFu; }
#define XB_SPIN(cond, bar) do { unsigned _sp = 0; while (cond) { __builtin_amdgcn_s_sleep(1); \
    if ((++_sp & 255u) == 0u) { if (xb_ld(&(bar)[XB_TMO])) break; if (_sp > XB_SPIN_CAP) { atomicAdd(&(bar)[XB_TMO], 1u); break; } } } } while (0)

struct XcdBarrier {
    unsigned* bar; unsigned x; int wave;
    volatile LAS unsigned* st;
};

__device__ __forceinline__ XcdBarrier xcd_barrier_post(unsigned* bar, volatile LAS unsigned* st, int wave) {
    XcdBarrier b; b.bar = bar; b.x = xb_xcc_id(); b.st = st; b.wave = wave;
    if (wave == 0 && mk_lane_id() == 0) (void)xb_add(&bar[XB_XCNT(b.x)], 1u);
    return b;
}
__device__ __forceinline__ void xcd_barrier_complete(unsigned* bar, unsigned x, unsigned& nloc, unsigned& nx) {
    const unsigned G = gridDim.x * gridDim.y * gridDim.z;
    unsigned sum, cnt, mine, sp = 0u;
    for (;;) {
        sum = 0u; cnt = 0u; mine = 0u;
#pragma unroll
        for (unsigned j = 0; j < 16; ++j) { const unsigned c = xb_ld(&bar[XB_XCNT(j)]); sum += c; cnt += (c > 0u) ? 1u : 0u; mine = (j == x) ? c : mine; }
        if (sum == G) break;
        __builtin_amdgcn_s_sleep(1);
        if ((++sp & 255u) == 0u) { if (xb_ld(&bar[XB_TMO])) break; if (sp > XB_SPIN_CAP) { atomicAdd(&bar[XB_TMO], 1u); break; } }
    }
    nloc = mine > 0u ? mine : 1u; nx = cnt > 0u ? cnt : 1u;
}

__device__ __forceinline__ void xcd_barrier(const XcdBarrier& b) {
    asm volatile("s_waitcnt vmcnt(0)" ::: "memory");
    __syncthreads();
    if (b.wave == 0 && mk_lane_id() == 0) {
        unsigned* bar = b.bar;
        __builtin_amdgcn_s_waitcnt(0);
        unsigned nloc = b.st[0], nx = b.st[1];
        if (nloc == 0u) { xcd_barrier_complete(bar, b.x, nloc, nx); b.st[0] = nloc; b.st[1] = nx; }
        const unsigned old = xb_add(&bar[XB_XSUB(b.x)], 1u);
        const unsigned gen = old / nloc;
        if (old + 1u == (gen + 1u) * nloc) {
            __builtin_amdgcn_fence(__ATOMIC_RELEASE, "agent");
            asm volatile("s_waitcnt vmcnt(0)" ::: "memory");
            const unsigned og = xb_add(&bar[XB_TOP], 1u);
            const unsigned tg = og / nx;
            if (og + 1u == (tg + 1u) * nx) xb_add(&bar[XB_TOPGEN], 1u);
            else XB_SPIN(xb_ld(&bar[XB_TOPGEN]) == tg, bar);
            __builtin_amdgcn_fence(__ATOMIC_ACQUIRE, "agent");
            xb_add(&bar[XB_XGEN(b.x)], 1u);
            asm volatile("s_waitcnt vmcnt(0)" ::: "memory");
        } else {
            XB_SPIN(xb_ld(&bar[XB_XGEN(b.x)]) == gen, bar);
            __builtin_amdgcn_fence(__ATOMIC_ACQUIRE, "agent");
            asm volatile("s_waitcnt vmcnt(0)" ::: "memory");
        }
    }
    __syncthreads();
}
#include <hip/hip_bf16.h>
#include <cmath>
namespace attn_body {
using bf16=__hip_bfloat16;
using bf16x8=__attribute__((ext_vector_type(8)))short;
using s16x4=__attribute__((ext_vector_type(4)))short;
using f32x16=__attribute__((ext_vector_type(16)))float;
using u32x4=__attribute__((ext_vector_type(4)))unsigned;
constexpr int BATCH=2,NHEAD=8,SEQ=8192,D=64,DM=2560;
constexpr int NW=8,QBLK=32,QB=QBLK*NW,KVBLK=64,NQB=SEQ/QB;
constexpr int ATTN_PITCH=DM, ATTN_UNIT_ROWS=QB;
__device__ __forceinline__ int crow(int r,int hi){return (r&3)+8*(r>>2)+4*hi;}
#define SBAR() __builtin_amdgcn_sched_barrier(0)
__device__ __forceinline__ void cmask(f32x16&p0,f32x16&p1,int jb,int qrel,int hi){
  const float NEG=-INFINITY; int kb=64*jb+4*hi;
  #pragma unroll
  for(int r=0;r<16;++r){int kv=kb+(r&3)+8*(r>>2); if(kv>qrel)p0[r]=NEG; if(kv+32>qrel)p1[r]=NEG;}
}

__device__ __forceinline__ float uni_f(float v){ float r; asm volatile("s_nop 1\n\tv_readfirstlane_b32 %0, %1\n\ts_nop 3" : "=s"(r) : "v"(v)); return r; }
constexpr int NSLOT=3, SLOTB=8192;
constexpr int LDS_K=0, LDS_V=NSLOT*SLOTB, LDS_WS=2*NSLOT*SLOTB, LDS_OST=LDS_WS+NW*64*4, LDS_BYTES=LDS_OST+NW*4096, LDS_KMI=86016  ;
constexpr float C2=0.125f*1.4426950408889634f;
__device__ __forceinline__ void glds16(const void*gsrc,unsigned lds_dst){unsigned keep;
  asm volatile("s_mov_b32 %0, m0\n\ts_mov_b32 m0, %2\n\ts_nop 0\n\tglobal_load_lds_dwordx4 %1, off\n\ts_mov_b32 m0, %0":"=&s"(keep):"v"(gsrc),"s"(lds_dst):"memory");}
__device__ __forceinline__ float max3f(float a,float b,float c){float r;asm("v_max3_f32 %0, %1, %2, %3":"=v"(r):"v"(a),"v"(b),"v"(c));return r;}
__device__ __forceinline__ float max2f(float a,float b){float r;asm("v_max_f32_e32 %0, %1, %2":"=v"(r):"v"(a),"v"(b));return r;}
__device__ __forceinline__ float fadd_s(float a,float b){float r;asm("v_add_f32_e32 %0, %1, %2":"=v"(r):"v"(a),"v"(b));return r;}
__device__ __forceinline__ float fsub_s(float a,float b){float r;asm("v_sub_f32_e32 %0, %1, %2":"=v"(r):"v"(a),"v"(b));return r;}
typedef float f32x2_t __attribute__((ext_vector_type(2))); typedef __bf16 bf16x2_t __attribute__((ext_vector_type(2)));
__device__ __forceinline__ unsigned cvtpk_s(float lo,float hi){f32x2_t v={lo,hi};bf16x2_t b=__builtin_convertvector(v,bf16x2_t);return __builtin_bit_cast(unsigned,b);}
#define WAIT_BAR(N) asm volatile("s_waitcnt vmcnt(" #N ") lgkmcnt(0)\n\ts_barrier":::"memory")

__device__ __forceinline__ void qkt(f32x16&p0,f32x16&p1,const char*Kslot,const bf16x8*qr,const f32x16&negm,int r32,int hi){
  const char*kb=Kslot+hi*1024+r32*16;
  #pragma unroll
  for(int d0=0;d0<4;++d0){
    const bf16x8 b0=*reinterpret_cast<const bf16x8*>(kb+d0*2048);
    const bf16x8 b1=*reinterpret_cast<const bf16x8*>(kb+d0*2048+512);
    if(d0==0){p0=__builtin_amdgcn_mfma_f32_32x32x16_bf16(b0,qr[0],negm,0,0,0);p1=__builtin_amdgcn_mfma_f32_32x32x16_bf16(b1,qr[0],negm,0,0,0);}
    else{p0=__builtin_amdgcn_mfma_f32_32x32x16_bf16(b0,qr[d0],p0,0,0,0);p1=__builtin_amdgcn_mfma_f32_32x32x16_bf16(b1,qr[d0],p1,0,0,0);}}
}
typedef __attribute__((address_space(3))) const char* lds_cptr;
typedef short v4i16_t __attribute__((ext_vector_type(4)));
__device__ __forceinline__ void kload8(bf16x8*kf,lds_cptr kp){
  kf[0]=*(const __attribute__((address_space(3))) bf16x8*)(kp);      kf[1]=*(const __attribute__((address_space(3))) bf16x8*)(kp+512);
  kf[2]=*(const __attribute__((address_space(3))) bf16x8*)(kp+2048); kf[3]=*(const __attribute__((address_space(3))) bf16x8*)(kp+2560);
  kf[4]=*(const __attribute__((address_space(3))) bf16x8*)(kp+4096); kf[5]=*(const __attribute__((address_space(3))) bf16x8*)(kp+4608);
  kf[6]=*(const __attribute__((address_space(3))) bf16x8*)(kp+6144); kf[7]=*(const __attribute__((address_space(3))) bf16x8*)(kp+6656);
}
__device__ __forceinline__ void kload2(bf16x8*kf,lds_cptr kp,int j){ kf[2*j]=*(const __attribute__((address_space(3))) bf16x8*)(kp+j*2048); kf[2*j+1]=*(const __attribute__((address_space(3))) bf16x8*)(kp+j*2048+512); }
__device__ __forceinline__ s16x4 vtr(lds_cptr p){ return __builtin_bit_cast(s16x4,__builtin_amdgcn_ds_read_tr16_b64_v4i16((__attribute__((address_space(3))) v4i16_t*)p)); }
__device__ __forceinline__ float rowmax(const f32x16&p0,const f32x16&p1){
  float a=max3f(p0[0],p0[1],p1[0]),b=max3f(p0[2],p0[3],p1[1]);a=max3f(a,p1[2],p1[3]);
  #pragma unroll
  for(int r=4;r<16;r+=4){a=max3f(a,p0[r],p0[r+1]);b=max3f(b,p0[r+2],p0[r+3]);a=max3f(a,p1[r],p1[r+1]);b=max3f(b,p1[r+2],p1[r+3]);}
  const float m=max2f(a,b);
  auto rr=__builtin_amdgcn_permlane32_swap(__float_as_uint(m),__float_as_uint(m),false,false);
  return max2f(__uint_as_float(rr[0]),__uint_as_float(rr[1]));
}
__device__ __forceinline__ void pv(f32x16*o,int vb,bf16x8 pa0,bf16x8 pa1,bf16x8 pa2,bf16x8 pa3){
  #pragma unroll
  for(int d0=0;d0<2;++d0){s16x4 lo[4],hi[4];
    #pragma unroll
    for(int ks=0;ks<4;++ks){
      asm volatile("ds_read_b64_tr_b16 %0,%1 offset:%c2":"=&v"(lo[ks]):"v"(vb),"i"(d0*4096+ks*1024):"memory");
      asm volatile("ds_read_b64_tr_b16 %0,%1 offset:%c2":"=&v"(hi[ks]):"v"(vb),"i"(d0*4096+ks*1024+512):"memory");}
    asm volatile("s_waitcnt lgkmcnt(0)":::"memory");SBAR();
    #define PK(k) (bf16x8){lo[k][0],lo[k][1],lo[k][2],lo[k][3],hi[k][0],hi[k][1],hi[k][2],hi[k][3]}
    o[d0]=__builtin_amdgcn_mfma_f32_32x32x16_bf16(pa0,PK(0),o[d0],0,0,0);
    o[d0]=__builtin_amdgcn_mfma_f32_32x32x16_bf16(pa1,PK(1),o[d0],0,0,0);
    o[d0]=__builtin_amdgcn_mfma_f32_32x32x16_bf16(pa2,PK(2),o[d0],0,0,0);
    o[d0]=__builtin_amdgcn_mfma_f32_32x32x16_bf16(pa3,PK(3),o[d0],0,0,0);
    #undef PK
  }
}

#ifndef ATTN_STORE16
#define ATTN_STORE16(p,v) (*(u32x4*)(p)=(v))
#endif
template<int THRL> __device__ __forceinline__ void attn_unit(int b,int h,int qb,const bf16*Q,const bf16*__restrict__ K,const bf16*__restrict__ V,bf16*O,const unsigned short*kmi,char*shm,const int wave_id){
  const int wid=wave_id,lane=mk_lane_id(),tid=wid*64+lane,r32=lane&31,hi=lane>>5;
  const long rowbase=(long)b*SEQ; const int q0=qb*QB;
  const bf16*Qw=Q+(rowbase+q0+wid*QBLK)*DM+h*D;
  const bf16*Kh=K+rowbase*DM+h*D,*Vh=V+rowbase*DM+h*D;
  const unsigned lds0=(unsigned)(uintptr_t)shm;
  float*wsf=(float*)(shm+LDS_WS)+wid*64;
  const bf16*ksrc=Kh+(long)lane*DM+wid*8;
  const bf16*vsrc=Vh+(long)(16*(wid&3)+(lane>>2))*DM+(wid>>2)*32+(lane&3)*8;
  const unsigned kdst=lds0+LDS_K+wid*1024, vdst=lds0+LDS_V+wid*1024;
  #define DMA_K(t,slot) glds16(ksrc+(long)(t)*KVBLK*DM,(unsigned)__builtin_amdgcn_readfirstlane(kdst+(slot)))
  #define DMA_V(t,slot) glds16(vsrc+(long)(t)*KVBLK*DM,(unsigned)__builtin_amdgcn_readfirstlane(vdst+(slot)))
  const int vb0=(int)(lds0+LDS_V)+((lane>>4)&1)*32+(lane&3)*8+(4*hi+((lane&15)>>2))*64;
  const char*Kbase=shm+LDS_K; bf16x8 kf[8];
  const lds_cptr shm3=(lds_cptr)shm; const lds_cptr kp0=shm3+LDS_K+hi*1024+r32*16; const lds_cptr vp0=shm3+LDS_V+((lane>>4)&1)*32+(lane&3)*8+(4*hi+((lane&15)>>2))*64;
  const int NT=(q0+QB)/KVBLK;
  DMA_K(0,0);DMA_V(0,0);DMA_K(1,SLOTB);
  bf16x8 qr[4];
  #pragma unroll
  for(int d0=0;d0<4;++d0)qr[d0]=*reinterpret_cast<const bf16x8*>(&Qw[(long)r32*DM+d0*16+hi*8]);
  if(tid<256)*(u32x4*)(shm+LDS_KMI+tid*16)=*(const u32x4*)(kmi+tid*8);
  const float sl=__builtin_amdgcn_exp2f(-(float)(h+1))*1.4426950408889634f;
  #define UNI(x) uni_f((float)(x))
  const float W41=UNI(__builtin_amdgcn_exp2f(sl)),W42=UNI(__builtin_amdgcn_exp2f(2.f*sl)),W43=UNI(__builtin_amdgcn_exp2f(3.f*sl));
  const float W81=UNI(__builtin_amdgcn_exp2f(8.f*sl)),W82=UNI(__builtin_amdgcn_exp2f(16.f*sl)),W83=UNI(__builtin_amdgcn_exp2f(24.f*sl));
  const float E32=UNI(__builtin_amdgcn_exp2f(32.f*sl)),sl64=UNI(64.f*sl),E4=UNI(__builtin_amdgcn_exp2f(4.f*sl));
  const float rE32=UNI(__builtin_amdgcn_exp2f(-32.f*sl));
  unsigned mask=0u;
  const int qrel=wid*QBLK+r32;
  #define CMASK(P0,P1,t) do{int jb_=(t)-(NT-4); if(jb_>=0)cmask(P0,P1,jb_,qrel,hi);}while(0)
  bool resc=false;
  #define SETNEG(t) do{ const bool sel_=((t)>=NT-4)||(((mask>>((t)>>2))&1u)!=0u); const float v_=sel_?nm:-INFINITY; \
    _Pragma("unroll") for(int r=0;r<16;++r)negm[r]=v_; asm volatile("":"+v"(negm)); }while(0)
  #define RESC() do{ if(resc){ asm volatile("s_waitcnt lgkmcnt(0)":::"memory"); \
      _Pragma("unroll") for(int d_=0;d_<2;++d_) _Pragma("unroll") for(int r=0;r<16;++r)o[d_][r]*=wsf[crow(r,hi)]; } }while(0)
  f32x16 pA0,pA1,pB0,pB1;
  int sl_prev=0,sl_cur=0,sl_next=SLOTB;
  #define ROT() do{sl_prev=sl_cur;sl_cur=sl_next;sl_next=(sl_next==(NSLOT-1)*SLOTB)?0:sl_next+SLOTB;}while(0)
  DMA_K(2,2*SLOTB);
  WAIT_BAR(3);
  float z0_; asm volatile("v_mov_b32 %0, 0":"=v"(z0_)); f32x16 zero16; _Pragma("unroll") for(int r=0;r<16;++r)zero16[r]=z0_;
  { f32x16 g=zero16; const char*kmb=shm+LDS_KMI+hi*512+r32*16;
    #pragma unroll
    for(int d0=0;d0<4;++d0){const bf16x8 a=*reinterpret_cast<const bf16x8*>(kmb+d0*1024); g=__builtin_amdgcn_mfma_f32_32x32x16_bf16(a,qr[d0],g,0,0,0);}
    float g1=-INFINITY,g2=-INFINITY,g3=-INFINITY;
    #pragma unroll
    for(int r=0;r<16;++r){const int j=crow(r,hi); float v=__uint_as_float((__float_as_uint(g[r])&~31u)|(unsigned)(31-j)); v=(j<qb)?v:-INFINITY;
      g3=__builtin_amdgcn_fmed3f(g2,g3,v); g2=__builtin_amdgcn_fmed3f(g1,g2,v); g1=__builtin_fmaxf(g1,v);}
    float t1=-INFINITY,t2=-INFINITY,t3=-INFINITY;
    #define INS3(v) do{const float v_=(v); t3=__builtin_amdgcn_fmed3f(t2,t3,v_); t2=__builtin_amdgcn_fmed3f(t1,t2,v_); t1=__builtin_fmaxf(t1,v_);}while(0)
    {auto rr=__builtin_amdgcn_permlane32_swap(__float_as_uint(g1),__float_as_uint(g1),false,false);INS3(__uint_as_float(rr[0]));INS3(__uint_as_float(rr[1]));}
    {auto rr=__builtin_amdgcn_permlane32_swap(__float_as_uint(g2),__float_as_uint(g2),false,false);INS3(__uint_as_float(rr[0]));INS3(__uint_as_float(rr[1]));}
    {auto rr=__builtin_amdgcn_permlane32_swap(__float_as_uint(g3),__float_as_uint(g3),false,false);INS3(__uint_as_float(rr[0]));INS3(__uint_as_float(rr[1]));}
    #undef INS3
    if(t1>-INFINITY)mask|=1u<<(31u-(__float_as_uint(t1)&31u));
    if(t2>-INFINITY)mask|=1u<<(31u-(__float_as_uint(t2)&31u));
    if(t3>-INFINITY)mask|=1u<<(31u-(__float_as_uint(t3)&31u)); }
  float nm=-sl*(float)q0,l_reg=0.f;f32x16 o[2];o[0]=zero16;o[1]=zero16;f32x16 negm=zero16;asm volatile("":"+v"(negm));
  SETNEG(0);
  qkt(pA0,pA1,Kbase,qr,negm,r32,hi);asm volatile("s_nop 15\n\ts_nop 7":"+v"(pA0),"+v"(pA1));CMASK(pA0,pA1,0);
  { const float rm=rowmax(pA0,pA1); const float dl=__builtin_fmaxf(rm,0.f); nm-=dl;
    _Pragma("unroll") for(int r=0;r<16;++r){pA0[r]-=dl;pA1[r]-=dl;} }
  _Pragma("unroll") for(int r=0;r<16;++r)pA0[r]=__builtin_amdgcn_exp2f(pA0[r]);
  _Pragma("unroll") for(int r=0;r<16;++r)pA1[r]=__builtin_amdgcn_exp2f(pA1[r]);
  nm+=sl64;
  WAIT_BAR(0);
  DMA_K(3,0);DMA_V(1,SLOTB);
  ROT();
  kload8(kf,kp0+sl_cur);
  WAIT_BAR(2);
  s16x4 vlo[8],vhi[8]; u32x4 pw0,pw1,pw2,pw3;
  #define PKW(P,B) cvtpk_s(P[B],P[B+1])
  #define PAF(k) __builtin_bit_cast(bf16x8,pw##k)
  #define VFR(i) (bf16x8){vlo[i][0],vlo[i][1],vlo[i][2],vlo[i][3],vhi[i][0],vhi[i][1],vhi[i][2],vhi[i][3]}
  #define PIN(x) asm volatile("":"+v"(x))
  #define MX3(a,b,c) __builtin_fmaxf(__builtin_fmaxf((a),(b)),(c))
  #define QS(P,b) __builtin_fmaf(P[4*(b)+3],W43,__builtin_fmaf(P[4*(b)+2],W42,__builtin_fmaf(P[4*(b)+1],W41,P[4*(b)])))
  #define GAPA(MF,F0,W0,W1,PW) do{ MF; F0; PIN(sacc); W0; W1; PIN(PW); SBAR(); }while(0)
  #define EX(v) __builtin_amdgcn_exp2f(v)
  #define GAPB(MF,X,B) do{ MF; X[B]=EX(X[B]); X[B+1]=EX(X[B+1]); X[B+2]=EX(X[B+2]); X[B+3]=EX(X[B+3]); PIN(X); SBAR(); }while(0)
  #define VRD(i) do{ vlo[i]=vtr(vp_+(((i)>>2)*4096+((i)&3)*1024)); vhi[i]=vtr(vp_+(((i)>>2)*4096+((i)&3)*1024+512)); }while(0)
  #define KRD(G,j) do{ if(G){ kload2(kf,kp0+sl_next,j); SBAR(); } }while(0)
  #define STEP(C0,C1,P0,P1,t,GK,GV,GL) do{ SBAR(); \
    const lds_cptr vp_=vp0+sl_prev; \
    SETNEG(t); \
    VRD(0); SBAR(); float sacc; \
    GAPA(C0=__builtin_amdgcn_mfma_f32_32x32x16_bf16(kf[0],qr[0],negm,0,0,0), sacc=QS(P0,0),                                   pw0[0]=PKW(P0,0), pw0[1]=PKW(P0,2), pw0); \
    VRD(4); SBAR(); GAPA(C1=__builtin_amdgcn_mfma_f32_32x32x16_bf16(kf[1],qr[0],negm,0,0,0), sacc=__builtin_fmaf(QS(P0,1),W81,sacc),   pw0[2]=PKW(P0,4), pw0[3]=PKW(P0,6), pw0); \
    VRD(1); SBAR(); GAPA(C0=__builtin_amdgcn_mfma_f32_32x32x16_bf16(kf[2],qr[1],C0,0,0,0),   sacc=__builtin_fmaf(QS(P0,2),W82,sacc),   pw1[0]=PKW(P0,8), pw1[1]=PKW(P0,10), pw1); \
    VRD(5); SBAR(); GAPA(C1=__builtin_amdgcn_mfma_f32_32x32x16_bf16(kf[3],qr[1],C1,0,0,0),   sacc=__builtin_fmaf(QS(P0,3),W83,sacc)*rE32, pw1[2]=PKW(P0,12),pw1[3]=PKW(P0,14), pw1); \
    VRD(2); SBAR(); GAPA(C0=__builtin_amdgcn_mfma_f32_32x32x16_bf16(kf[4],qr[2],C0,0,0,0),   sacc+=QS(P1,0),                           pw2[0]=PKW(P1,0), pw2[1]=PKW(P1,2), pw2); \
    VRD(6); SBAR(); GAPA(C1=__builtin_amdgcn_mfma_f32_32x32x16_bf16(kf[5],qr[2],C1,0,0,0),   sacc=__builtin_fmaf(QS(P1,1),W81,sacc),   pw2[2]=PKW(P1,4), pw2[3]=PKW(P1,6), pw2); \
    VRD(3); SBAR(); GAPA(C0=__builtin_amdgcn_mfma_f32_32x32x16_bf16(kf[6],qr[3],C0,0,0,0),   sacc=__builtin_fmaf(QS(P1,2),W82,sacc),   pw3[0]=PKW(P1,8), pw3[1]=PKW(P1,10), pw3); \
    VRD(7); SBAR(); GAPA(C1=__builtin_amdgcn_mfma_f32_32x32x16_bf16(kf[7],qr[3],C1,0,0,0),   sacc=__builtin_fmaf(QS(P1,3),W83,sacc),   pw3[2]=PKW(P1,12),pw3[3]=PKW(P1,14), pw3); \
    l_reg=__builtin_fmaf(sacc,E32,l_reg); \
    if(GK){DMA_K((t)+3,sl_cur);} if(GV){DMA_V((t)+1,sl_next);} \
    CMASK(C0,C1,t); \
    { float a=MX3(C0[0],C0[1],C1[0]),b=MX3(C0[2],C0[3],C1[1]); a=MX3(a,C1[2],C1[3]); \
      _Pragma("unroll") for(int r=4;r<16;r+=4){a=MX3(a,C0[r],C0[r+1]);b=MX3(b,C0[r+2],C0[r+3]);a=MX3(a,C1[r],C1[r+1]);b=MX3(b,C1[r+2],C1[r+3]);} \
      float rm=__builtin_fmaxf(a,b); { auto rr=__builtin_amdgcn_permlane32_swap(__float_as_uint(rm),__float_as_uint(rm),false,false); rm=__builtin_fmaxf(__uint_as_float(rr[0]),__uint_as_float(rr[1])); } \
      resc=false; \
      if(__builtin_expect(__any(rm>(float)THRL),0)){ const float dl=__builtin_fmaxf(rm,0.f); nm-=dl; \
        _Pragma("unroll") for(int r=0;r<16;++r){C0[r]-=dl;C1[r]-=dl;} \
        const float f=__builtin_amdgcn_exp2f(-dl); l_reg*=f; if(hi==0)wsf[r32]=f; resc=true; } } \
    nm+=sl64; \
    SBAR(); \
    GAPB(o[0]=__builtin_amdgcn_mfma_f32_32x32x16_bf16(PAF(0),VFR(0),o[0],0,0,0), C0,0); \
    GAPB(o[1]=__builtin_amdgcn_mfma_f32_32x32x16_bf16(PAF(0),VFR(4),o[1],0,0,0), C0,4); \
    KRD(GL,0); GAPB(o[0]=__builtin_amdgcn_mfma_f32_32x32x16_bf16(PAF(1),VFR(1),o[0],0,0,0), C0,8); \
    KRD(GL,1); GAPB(o[1]=__builtin_amdgcn_mfma_f32_32x32x16_bf16(PAF(1),VFR(5),o[1],0,0,0), C0,12); \
    KRD(GL,2); GAPB(o[0]=__builtin_amdgcn_mfma_f32_32x32x16_bf16(PAF(2),VFR(2),o[0],0,0,0), C1,0); \
    KRD(GL,3); GAPB(o[1]=__builtin_amdgcn_mfma_f32_32x32x16_bf16(PAF(2),VFR(6),o[1],0,0,0), C1,4); \
    GAPB(o[0]=__builtin_amdgcn_mfma_f32_32x32x16_bf16(PAF(3),VFR(3),o[0],0,0,0), C1,8); \
    GAPB(o[1]=__builtin_amdgcn_mfma_f32_32x32x16_bf16(PAF(3),VFR(7),o[1],0,0,0), C1,12); \
    }while(0)
  int t=1;
  #undef CMASK
  #define CMASK(P0,P1,t) do{}while(0)
  for(;t+5<NT;t+=2){
    STEP(pB0,pB1,pA0,pA1,t,true,true,true);     WAIT_BAR(2); RESC(); ROT();
    STEP(pA0,pA1,pB0,pB1,t+1,true,true,true);   WAIT_BAR(2); RESC(); ROT();
  }
  #undef CMASK
  #define CMASK(P0,P1,t) do{int jb_=(t)-(NT-4); if(jb_>=0)cmask(P0,P1,jb_,qrel,hi);}while(0)
  #define ENDW(tt) do{ if((tt)+3<NT){WAIT_BAR(2);} else if((tt)+2<NT){WAIT_BAR(1);} else {WAIT_BAR(0);} }while(0)
  for(;t+1<NT;t+=2){
    STEP(pB0,pB1,pA0,pA1,t,(t+3<NT),(t+1<NT),(t+1<NT));       ENDW(t);   RESC(); ROT();
    STEP(pA0,pA1,pB0,pB1,t+1,(t+4<NT),(t+2<NT),(t+2<NT));     ENDW(t+1); RESC(); ROT();
  }
  STEP(pB0,pB1,pA0,pA1,NT-1,false,false,false); RESC();
  { const float sacc=__builtin_fmaf(QS(pB0,3),W83,__builtin_fmaf(QS(pB0,2),W82,__builtin_fmaf(QS(pB0,1),W81,QS(pB0,0)))), sacd=__builtin_fmaf(QS(pB1,3),W83,__builtin_fmaf(QS(pB1,2),W82,__builtin_fmaf(QS(pB1,1),W81,QS(pB1,0)))); l_reg+=sacc+sacd*E32;
    pw0=(u32x4){PKW(pB0,0),PKW(pB0,2),PKW(pB0,4),PKW(pB0,6)};pw1=(u32x4){PKW(pB0,8),PKW(pB0,10),PKW(pB0,12),PKW(pB0,14)};pw2=(u32x4){PKW(pB1,0),PKW(pB1,2),PKW(pB1,4),PKW(pB1,6)};pw3=(u32x4){PKW(pB1,8),PKW(pB1,10),PKW(pB1,12),PKW(pB1,14)};
    SBAR(); pv(o,vb0+sl_cur,PAF(0),PAF(1),PAF(2),PAF(3)); }
  #undef PKW
  #undef PAF
  #undef VFR
  #undef PIN
  #undef MX3
  #undef GAPA
  #undef QS
  #undef GAPB
  #undef EX
  #undef VRD
  #undef KRD
  #undef STEP
  #undef ENDW
  const int lane_e=mk_lane_id(),r32e=lane_e&31,hie=lane_e>>5;
  l_reg*=hie?E4:1.f;
  {auto rr=__builtin_amdgcn_permlane32_swap(__float_as_uint(l_reg),__float_as_uint(l_reg),false,false);l_reg=__uint_as_float(rr[0])+__uint_as_float(rr[1]);}
  if(hie==0)wsf[32+r32e]=l_reg;asm volatile("s_waitcnt lgkmcnt(0)":::"memory");
  float rli[16];
  #pragma unroll
  for(int r=0;r<16;++r)rli[r]=__builtin_amdgcn_rcpf(wsf[32+crow(r,hie)]);
  bf16*Ow=O+(rowbase+q0+wid*QBLK)*DM+h*D;
  { bf16*stg=(bf16*)(shm+LDS_OST)+wid*2048;
    #pragma unroll
    for(int r=0;r<16;++r){const int orow=crow(r,hie);
      #pragma unroll
      for(int d0=0;d0<2;++d0)stg[orow*64+d0*32+r32e]=__float2bfloat16(o[d0][r]*rli[r]);}
    asm volatile("s_waitcnt lgkmcnt(0)":::"memory");
    #pragma unroll
    for(int i=0;i<4;++i){const int row=i*8+(lane_e>>3),ch=lane_e&7; const u32x4 v=*(const u32x4*)(stg+row*64+ch*8); ATTN_STORE16(Ow+(long)row*DM+ch*8,v);} }
  asm volatile("s_waitcnt lgkmcnt(0)\n\ts_barrier":::"memory");
  #undef DMA_K
  #undef DMA_V
  #undef CMASK
  #undef SETNEG
  #undef UNI
  #undef RESC
  #undef ROT
}
constexpr int ATTN_LDS_BYTES=LDS_BYTES;
struct AttnTensors { const bf16* Q; const bf16* K; const bf16* V; bf16* O; };
struct AttnUnit { int bh; int qb; };
struct StaticOrder {
  int vcu;
  __device__ __forceinline__ explicit StaticOrder(int grid,int block):vcu((grid%8==0)?(block%8)*(grid/8)+block/8:block){}
  __device__ __forceinline__ bool next(int i,AttnUnit&u)const{ const int id=2*vcu+i; if(i>=2||id>=512)return false; const int s=vcu&15; u.bh=vcu>>4; u.qb=(i==0)?31-s:s; return true; }
  __device__ __forceinline__ void a_ready(const AttnUnit&)const{}
  __device__ __forceinline__ void done(const AttnUnit&)const{}
};
template<class Sched,int THRL=8> __device__ __forceinline__ void attn_phase(char*lds,const AttnTensors&T,const unsigned short*kmi,const Sched&S,const int wave_id){
  AttnUnit u;
  for(int i=0;S.next(i,u);++i){ S.a_ready(u); attn_unit<THRL>(u.bh/NHEAD,u.bh%NHEAD,u.qb,T.Q,T.K,T.V,T.O,kmi+(long)u.bh*2048,lds,wave_id); S.done(u); }
}
#undef SBAR
#undef WAIT_BAR
}

constexpr int NWAVES = 8;
constexpr int NB = 2, SEQ = 8192, D = 1024, M = NB * SEQ;
constexpr int NH = 8, HD = 64;
constexpr int MOBA_BLK = 256, NBLK = SEQ / MOBA_BLK;
constexpr int INC = 4608;
constexpr int ZC = 2560;
constexpr int ZQ = 0, ZK = 512, ZV = 1024, ZGU = 1536, ZGV = 2048;
constexpr int GC = 2048;
constexpr int PQC = 2048;
constexpr int NEXP = 16384;
constexpr float LN_EPS = 1e-5f;
constexpr float ALPHA = 1.189207115002721f;
constexpr float LOG2E = 1.4426950408889634f;
constexpr float C2 = 0.125f * LOG2E;
constexpr float USCALE = 64.0f, VSCALE = 4.0f;

constexpr size_t MiB = 1u << 20;
constexpr size_t WS_CTL = 0, CTL_ZERO_BYTES = 1 * MiB;
constexpr size_t WS_MOD = 1 * MiB;
constexpr size_t WS_KMEAN = 1 * MiB + 64 * 1024;
constexpr size_t WS_WIN = 2 * MiB;
constexpr size_t WS_WA = 11 * MiB, WS_WG = 12 * MiB;
constexpr size_t WS_WOUT = 13 * MiB;
constexpr size_t WS_WPQ = 15 * MiB;
constexpr size_t WS_U8 = 20 * MiB, WS_V8 = 36 * MiB;
constexpr size_t WS_XN = 84 * MiB;
constexpr size_t WS_ZC = 116 * MiB;
constexpr size_t WS_TS = 180 * MiB;
constexpr size_t WS_IDX = 196 * MiB, WS_GW = 204 * MiB;
constexpr size_t WS_END = 212 * MiB;
constexpr int CW_BAR = 4096;

constexpr int RING_BYTES = 131072;
constexpr int LDSCTL_OFF = RING_BYTES, MISC_OFF = LDSCTL_OFF + 320;
constexpr int LDS_BYTES = 147456;

struct Frame {
    LAS unsigned char* lds;
    volatile LAS unsigned* MISC;
    gu32* ctl;
    int wave, G;
    const float *x, *c, *w_cond, *b_cond, *w_in, *w_attn_up, *w_gmlp_up, *w_out, *sgu_ln_g, *sgu_ln_b, *w_spatial, *b_spatial, *ln1_g, *ln1_b, *w_peer_q, *sub_keys, *peer_u, *peer_v, *ln2_g, *ln2_b;
    float* out;
    float *mod, *ts, *gw; int* idx; bf16* kmi;
    bf16 *win_t, *wa_t, *wg_t, *wout_t, *wpq_t, *xn, *zc, *pq, *gates; unsigned char *u8, *v8;
};

__device__ __forceinline__ float wave_sum(float v) {
#pragma unroll
    for (int o = 1; o < 64; o <<= 1) v += __shfl_xor(v, o);
    return v;
}
__device__ __forceinline__ float bflo(unsigned w) { return __uint_as_float(w << 16); }
__device__ __forceinline__ float bfhi(unsigned w) { return __uint_as_float(w & 0xffff0000u); }
__device__ __forceinline__ float silu1(float x) { return x / (1.0f + __expf(-x)); }
__device__ __forceinline__ float gelu_erf(float x) { return 0.5f * x * (1.0f + erff(x * 0.70710678118654752f)); }

__device__ __forceinline__ void p0_transpose_item(const float* W, int K, int N, bf16* WT, LAS float* scr, int item, int lane) {
    const int nblk = N / 32, kb = item / nblk, nb = item % nblk, k0 = 64 * kb, n0 = 32 * nb;
#pragma unroll 8
    for (int i = 0; i < 32; ++i) { const int kk = 2 * i + (lane >> 5); scr[kk * 33 + (lane & 31)] = W[(size_t)(k0 + kk) * N + n0 + (lane & 31)]; }
    LDS_WAIT(); asm volatile("" ::: "memory");
    const int c = lane & 7;
#pragma unroll
    for (int j = 0; j < 4; ++j) { const int n = (lane >> 3) + 8 * j; const LAS float* s = scr + (8 * c) * 33 + n;
        v4u o; o.x = pk2(s[0 * 33], s[1 * 33]); o.y = pk2(s[2 * 33], s[3 * 33]); o.z = pk2(s[4 * 33], s[5 * 33]); o.w = pk2(s[6 * 33], s[7 * 33]);
        *(GAS v4u*)(WT + (size_t)(n0 + n) * K + k0 + 8 * c) = o; }
    LDS_WAIT(); asm volatile("" ::: "memory");
}

__device__ __forceinline__ void p0_prologue(Frame& F) {
    const int LANE = mk_lane_id(), TID = F.wave * 64 + LANE;
    {
        LAS float* part = (LAS float*)F.lds;
        for (int cg = blockIdx.x; cg < 256; cg += F.G) {
            if (TID < 384) {
                const int col = TID % 24, ks = TID / 24, j = 24 * cg + col;
                float a0 = 0.f, a1 = 0.f;
                for (int k = 64 * ks; k < 64 * ks + 64; ++k) {
                    const float wv = F.w_cond[(size_t)k * 6144 + j];
                    a0 += silu1(F.c[k]) * wv; a1 += silu1(F.c[1024 + k]) * wv;
                }
                part[(ks * 24 + col) * 2 + 0] = a0; part[(ks * 24 + col) * 2 + 1] = a1;
            }
            __syncthreads();
            if (TID < 48) {
                const int col = TID % 24, b = TID / 24; float s = F.b_cond[24 * cg + col];
                for (int ks = 0; ks < 16; ++ks) s += part[(ks * 24 + col) * 2 + b];
                F.mod[b * 6144 + 24 * cg + col] = s;
            }
            __syncthreads();
        }
    }
    {
        LAS float* scr = (LAS float*)(F.lds + F.wave * 16384);
        const int gw = blockIdx.x * NWAVES + F.wave, NGW = F.G * NWAVES;
        constexpr int I_IN = (D / 64) * (INC / 32), I_UP = (512 / 64) * (D / 32), I_OUT = (D / 64) * (D / 32), I_PQ = (D / 64) * (PQC / 32);
        constexpr int NITEMS = I_IN + 2 * I_UP + I_OUT + I_PQ;
        for (int it = gw; it < NITEMS; it += NGW) {
            int r = it;
            if (r < I_IN) { p0_transpose_item(F.w_in, D, INC, F.win_t, scr, r, LANE); continue; } r -= I_IN;
            if (r < I_UP) { p0_transpose_item(F.w_attn_up, 512, D, F.wa_t, scr, r, LANE); continue; } r -= I_UP;
            if (r < I_UP) { p0_transpose_item(F.w_gmlp_up, 512, D, F.wg_t, scr, r, LANE); continue; } r -= I_UP;
            if (r < I_OUT) { p0_transpose_item(F.w_out, D, D, F.wout_t, scr, r, LANE); continue; } r -= I_OUT;
            p0_transpose_item(F.w_peer_q, D, PQC, F.wpq_t, scr, r, LANE);
        }
    }
    {
        const size_t n16 = (size_t)NEXP * D / 16;
        const size_t gt = (size_t)blockIdx.x * (NWAVES * 64) + TID, NT = (size_t)F.G * (NWAVES * 64);
        for (size_t i = gt; i < 2 * n16; i += NT) {
            const bool second = i >= n16; const size_t j = second ? i - n16 : i; const float sc = second ? VSCALE : USCALE;
            const f32x4* sp = (const f32x4*)((second ? F.peer_v : F.peer_u) + j * 16);
            v4u o;
#pragma unroll
            for (int q = 0; q < 4; ++q) { const f32x4 a = sp[q] * sc; int w = __builtin_amdgcn_cvt_pk_fp8_f32(a.x, a.y, 0, false); w = __builtin_amdgcn_cvt_pk_fp8_f32(a.z, a.w, w, true); o[q] = (unsigned)w; }
            *(v4u*)((second ? F.v8 : F.u8) + j * 16) = o;
        }
    }
}

__device__ __forceinline__ void p1_modulate(Frame& F) {
    const int LANE = mk_lane_id(), TID = F.wave * 64 + LANE;
    const int gw = blockIdx.x * NWAVES + F.wave, NGW = F.G * NWAVES;
    for (int m = gw; m < M; m += NGW) {
        const int b = m >> 13;
        const f32x4* xr = (const f32x4*)(F.x + (size_t)m * D) + LANE;
        f32x4 v[4]; float s = 0.f;
#pragma unroll
        for (int j = 0; j < 4; ++j) { v[j] = xr[64 * j]; s += (v[j].x + v[j].y) + (v[j].z + v[j].w); }
        const float mean = wave_sum(s) * (1.f / D); float s2 = 0.f;
#pragma unroll
        for (int j = 0; j < 4; ++j) { v[j] = v[j] - mean; s2 += (v[j].x * v[j].x + v[j].y * v[j].y) + (v[j].z * v[j].z + v[j].w * v[j].w); }
        const float rstd = 1.f / sqrtf(wave_sum(s2) * (1.f / D) + LN_EPS);
        unsigned long long* o8 = (unsigned long long*)(F.xn + (size_t)m * D) + LANE;
#pragma unroll
        for (int j = 0; j < 4; ++j) {
            const int col = 4 * LANE + 256 * j;
            const f32x4 sh = *(const f32x4*)(F.mod + b * 6144 + col), sc = *(const f32x4*)(F.mod + b * 6144 + 1024 + col);
            const f32x4 y = v[j] * rstd * (sc + 1.0f) + sh;
            o8[64 * j] = (unsigned long long)pk2(y.x, y.y) | ((unsigned long long)pk2(y.z, y.w) << 32);
        }
    }
}

__device__ __forceinline__ void p3_kmean(Frame& F) {
    const int LANE = mk_lane_id(), TID = F.wave * 64 + LANE;
    const int gt = blockIdx.x * (NWAVES * 64) + TID, NT = F.G * (NWAVES * 64);
    for (int i = gt; i < NB * NBLK * 512; i += NT) {
        const int col = i & 511, bb = i >> 9, b = bb >> 5, blk = bb & 31, h = col >> 6, d = col & 63;
        const bf16* p = F.zc + (size_t)bb * 256 * ZC + ZK + col;
        float s = 0.f;
        for (int r = 0; r < 256; ++r) s += bflo((unsigned)p[(size_t)r * ZC]);
        F.kmi[(size_t)(b * 8 + h) * 2048 + (d >> 3) * 256 + blk * 8 + (d & 7)] = (bf16)f2bf(s * (1.0f / 256.0f));
    }
}

__device__ __forceinline__ void p3_sgu(Frame& F) {
    const int LANE = mk_lane_id(), TID = F.wave * 64 + LANE;
    LAS float* vvn = (LAS float*)F.lds;
    LAS float* wsp = (LAS float*)(F.lds + 32768);
    const int t = TID >> 2, dq = TID & 3;
    for (int u = blockIdx.x; u < 1024; u += F.G) {
        const int chunk = u >> 3, g = u & 7; const size_t row0 = (size_t)chunk * 128;
        __syncthreads();
        {
            const bf16* p = F.zc + (row0 + t) * ZC + ZGV + g * 64 + dq * 16;
            const v4u w0 = *(const v4u*)p, w1 = *(const v4u*)(p + 8);
            float v[16];
            v[0] = bflo(w0.x); v[1] = bfhi(w0.x); v[2] = bflo(w0.y); v[3] = bfhi(w0.y); v[4] = bflo(w0.z); v[5] = bfhi(w0.z); v[6] = bflo(w0.w); v[7] = bfhi(w0.w);
            v[8] = bflo(w1.x); v[9] = bfhi(w1.x); v[10] = bflo(w1.y); v[11] = bfhi(w1.y); v[12] = bflo(w1.z); v[13] = bfhi(w1.z); v[14] = bflo(w1.w); v[15] = bfhi(w1.w);
            float s = 0.f;
#pragma unroll
            for (int k = 0; k < 16; ++k) s += v[k];
            s += __shfl_xor(s, 1); s += __shfl_xor(s, 2);
            const float mean = s * (1.0f / 64.0f); float q = 0.f;
#pragma unroll
            for (int k = 0; k < 16; ++k) { v[k] -= mean; q += v[k] * v[k]; }
            q += __shfl_xor(q, 1); q += __shfl_xor(q, 2);
            const float rstd = 1.f / sqrtf(q * (1.0f / 64.0f) + LN_EPS);
#pragma unroll
            for (int k = 0; k < 16; ++k) { const int d = dq * 16 + k; vvn[t * 64 + d] = v[k] * rstd * F.sgu_ln_g[g * 64 + d] + F.sgu_ln_b[g * 64 + d]; }
        }
        for (int i = TID; i < 16384; i += NWAVES * 64) wsp[(i >> 7) * 129 + (i & 127)] = F.w_spatial[(size_t)g * 16384 + i];
        __syncthreads();
        float acc[16];
#pragma unroll
        for (int k = 0; k < 16; ++k) acc[k] = 0.f;
        for (int s = 0; s <= t; ++s) {
            const float wv = wsp[t * 129 + s];
            const LAS f32x4* vp = (const LAS f32x4*)(vvn + s * 64 + dq * 16);
#pragma unroll
            for (int k4 = 0; k4 < 4; ++k4) { const f32x4 x = vp[k4]; acc[4 * k4 + 0] += wv * x.x; acc[4 * k4 + 1] += wv * x.y; acc[4 * k4 + 2] += wv * x.z; acc[4 * k4 + 3] += wv * x.w; }
        }
        const float bsp = F.b_spatial[g * 128 + t];
        bf16* up = F.zc + (row0 + t) * ZC + ZGU + g * 64 + dq * 16;
        const v4u u0 = *(const v4u*)up, u1 = *(const v4u*)(up + 8);
        v4u o0, o1;
        o0.x = pk2(bflo(u0.x) * (acc[0] + bsp), bfhi(u0.x) * (acc[1] + bsp)); o0.y = pk2(bflo(u0.y) * (acc[2] + bsp), bfhi(u0.y) * (acc[3] + bsp));
        o0.z = pk2(bflo(u0.z) * (acc[4] + bsp), bfhi(u0.z) * (acc[5] + bsp)); o0.w = pk2(bflo(u0.w) * (acc[6] + bsp), bfhi(u0.w) * (acc[7] + bsp));
        o1.x = pk2(bflo(u1.x) * (acc[8] + bsp), bfhi(u1.x) * (acc[9] + bsp)); o1.y = pk2(bflo(u1.y) * (acc[10] + bsp), bfhi(u1.y) * (acc[11] + bsp));
        o1.z = pk2(bflo(u1.z) * (acc[12] + bsp), bfhi(u1.z) * (acc[13] + bsp)); o1.w = pk2(bflo(u1.w) * (acc[14] + bsp), bfhi(u1.w) * (acc[15] + bsp));
        *(v4u*)up = o0; *(v4u*)(up + 8) = o1;
    }
    __syncthreads();
}

__device__ __forceinline__ void p7_ln(Frame& F) {
    const int LANE = mk_lane_id(), TID = F.wave * 64 + LANE;
    const int gw = blockIdx.x * NWAVES + F.wave, NGW = F.G * NWAVES;
    for (int m = gw; m < M; m += NGW) {
        const int b = m >> 13;
        f32x4* xr = (f32x4*)(F.out + (size_t)m * D) + LANE;
        f32x4 v[4]; float s = 0.f;
#pragma unroll
        for (int j = 0; j < 4; ++j) { v[j] = xr[64 * j]; s += (v[j].x + v[j].y) + (v[j].z + v[j].w); }
        float mean = wave_sum(s) * (1.f / D); float s2 = 0.f;
#pragma unroll
        for (int j = 0; j < 4; ++j) { v[j] = v[j] - mean; s2 += (v[j].x * v[j].x + v[j].y * v[j].y) + (v[j].z * v[j].z + v[j].w * v[j].w); }
        float rstd = 1.f / sqrtf(wave_sum(s2) * (1.f / D) + LN_EPS);
        s = 0.f;
#pragma unroll
        for (int j = 0; j < 4; ++j) {
            const int col = 4 * LANE + 256 * j;
            v[j] = v[j] * rstd * *(const f32x4*)(F.ln1_g + col) + *(const f32x4*)(F.ln1_b + col);
            xr[64 * j] = v[j];
            s += (v[j].x + v[j].y) + (v[j].z + v[j].w);
        }
        mean = wave_sum(s) * (1.f / D); s2 = 0.f;
#pragma unroll
        for (int j = 0; j < 4; ++j) { v[j] = v[j] - mean; s2 += (v[j].x * v[j].x + v[j].y * v[j].y) + (v[j].z * v[j].z + v[j].w * v[j].w); }
        rstd = 1.f / sqrtf(wave_sum(s2) * (1.f / D) + LN_EPS);
        unsigned long long* o8 = (unsigned long long*)(F.xn + (size_t)m * D) + LANE;
#pragma unroll
        for (int j = 0; j < 4; ++j) {
            const int col = 4 * LANE + 256 * j;
            const f32x4 sh = *(const f32x4*)(F.mod + b * 6144 + 3072 + col), sc = *(const f32x4*)(F.mod + b * 6144 + 4096 + col);
            const f32x4 y = v[j] * rstd * (sc + 1.0f) + sh;
            o8[64 * j] = (unsigned long long)pk2(y.x, y.y) | ((unsigned long long)pk2(y.z, y.w) << 32);
        }
    }
}

__device__ __forceinline__ void ins16(float (&L)[16], float v) {
#pragma unroll
    for (int i = 15; i >= 1; --i) L[i] = __builtin_amdgcn_fmed3f(L[i - 1], L[i], v);
    L[0] = fmaxf(L[0], v);
}
__device__ __forceinline__ void p9_topk_simple(Frame& F) {
    const int LANE = mk_lane_id(), TID = F.wave * 64 + LANE;
    LAS float* Kl = (LAS float*)F.lds;
    for (int u = blockIdx.x; u < 512; u += F.G) {
        const int hc = u & 15, tb = u >> 4;
        __syncthreads();
        for (int i = TID; i < 16384; i += NWAVES * 64) Kl[i] = F.sub_keys[(size_t)hc * 16384 + i];
        __syncthreads();
        const int t = tb * 512 + TID;
        const bf16* qp = F.pq + (size_t)t * PQC + hc * 128;
        float q[128];
#pragma unroll
        for (int i = 0; i < 16; ++i) { const v4u w = *(const v4u*)(qp + 8 * i);
            q[8 * i + 0] = bflo(w.x); q[8 * i + 1] = bfhi(w.x); q[8 * i + 2] = bflo(w.y); q[8 * i + 3] = bfhi(w.y);
            q[8 * i + 4] = bflo(w.z); q[8 * i + 5] = bfhi(w.z); q[8 * i + 6] = bflo(w.w); q[8 * i + 7] = bfhi(w.w); }
        float L[16];
#pragma unroll
        for (int i = 0; i < 16; ++i) L[i] = -INFINITY;
        for (int n = 0; n < 128; ++n) {
            const LAS f32x4* kp = (const LAS f32x4*)(Kl + n * 128);
            float d0 = 0.f, d1 = 0.f;
#pragma unroll
            for (int d4 = 0; d4 < 32; d4 += 2) { const f32x4 a = kp[d4], c = kp[d4 + 1];
                d0 += q[4 * d4] * a.x + q[4 * d4 + 1] * a.y + q[4 * d4 + 2] * a.z + q[4 * d4 + 3] * a.w;
                d1 += q[4 * d4 + 4] * c.x + q[4 * d4 + 5] * c.y + q[4 * d4 + 6] * c.z + q[4 * d4 + 7] * c.w; }
            const float dot = d0 + d1;
            ins16(L, __uint_as_float((__float_as_uint(dot) & ~127u) | (unsigned)n));
        }
        f32x4* o = (f32x4*)(F.ts + ((size_t)t * 16 + hc) * 16);
#pragma unroll
        for (int i = 0; i < 4; ++i) o[i] = (f32x4){L[4 * i], L[4 * i + 1], L[4 * i + 2], L[4 * i + 3]};
    }
    __syncthreads();
}

__device__ __forceinline__ void p9b_combine(Frame& F) {
    const int LANE = mk_lane_id(), TID = F.wave * 64 + LANE;
    const int gt = blockIdx.x * (NWAVES * 64) + TID, NT = F.G * (NWAVES * 64);
    for (int i = gt; i < M * 8; i += NT) {
        const int t = i >> 3, h = i & 7;
        const float* l0 = F.ts + ((size_t)t * 16 + 2 * h) * 16; const float* l1 = l0 + 16;
        float A[16], B[16];
#pragma unroll
        for (int k = 0; k < 4; ++k) { const f32x4 a = ((const f32x4*)l0)[k], b = ((const f32x4*)l1)[k];
            A[4 * k] = a.x; A[4 * k + 1] = a.y; A[4 * k + 2] = a.z; A[4 * k + 3] = a.w; B[4 * k] = b.x; B[4 * k + 1] = b.y; B[4 * k + 2] = b.z; B[4 * k + 3] = b.w; }
#pragma unroll
        for (int k = 0; k < 16; ++k) { A[k] = __uint_as_float(__float_as_uint(A[k]) & ~127u); B[k] = __uint_as_float(__float_as_uint(B[k]) & ~127u); }
        float R[16];
#pragma unroll
        for (int k = 0; k < 16; ++k) R[k] = -INFINITY;
#pragma unroll
        for (int a = 0; a < 16; ++a)
#pragma unroll
            for (int b = 0; b < 16; ++b)
                if ((a + 1) * (b + 1) <= 16) ins16(R, __uint_as_float((__float_as_uint(A[a] + B[b]) & ~255u) | (unsigned)(a * 16 + b)));
        float e[16]; float sum = 0.f; const float r0 = __uint_as_float(__float_as_uint(R[0]) & ~255u);
#pragma unroll
        for (int k = 0; k < 16; ++k) { e[k] = __expf(__uint_as_float(__float_as_uint(R[k]) & ~255u) - r0); sum += e[k]; }
        const float inv = 1.0f / sum;
#pragma unroll
        for (int k = 0; k < 16; ++k) {
            const unsigned bits = __float_as_uint(R[k]); const int a = (bits >> 4) & 15, b = bits & 15;
            const int i1 = (int)(__float_as_uint(l0[a]) & 127u), i2 = (int)(__float_as_uint(l1[b]) & 127u);
            F.idx[(size_t)t * 128 + h * 16 + k] = i1 * 128 + i2;
            F.gw[(size_t)t * 128 + h * 16 + k] = e[k] * inv;
        }
    }
}

typedef float f32x2v __attribute__((ext_vector_type(2)));
__device__ __forceinline__ float dot16_fp8(const f32x2v (&h2)[8], v4u u) {
    f32x2v acc = {0.f, 0.f};
#pragma unroll
    for (int w = 0; w < 4; ++w) {
        const f32x2v lo = __builtin_amdgcn_cvt_pk_f32_fp8((int)u[w], false), hi = __builtin_amdgcn_cvt_pk_f32_fp8((int)u[w], true);
        acc = __builtin_elementwise_fma(lo, h2[2 * w], acc); acc = __builtin_elementwise_fma(hi, h2[2 * w + 1], acc);
    }
    return acc.x + acc.y;
}
__device__ __forceinline__ void p10_peer(Frame& F) {
    const int LANE = mk_lane_id();
    const int gw = blockIdx.x * NWAVES + F.wave, NGW = F.G * NWAVES;
    const bool b0 = (LANE & 1) != 0, b1 = (LANE & 2) != 0, b2 = (LANE & 4) != 0;
    for (int m = gw; m < M; m += NGW) {
        const int b = m >> 13;
        f32x2v h2[8];
        {   const bf16* hp = F.xn + (size_t)m * D + LANE * 16;
            const v4u w0 = *(const v4u*)hp, w1 = *(const v4u*)(hp + 8);
            h2[0] = (f32x2v){bflo(w0.x), bfhi(w0.x)}; h2[1] = (f32x2v){bflo(w0.y), bfhi(w0.y)}; h2[2] = (f32x2v){bflo(w0.z), bfhi(w0.z)}; h2[3] = (f32x2v){bflo(w0.w), bfhi(w0.w)};
            h2[4] = (f32x2v){bflo(w1.x), bfhi(w1.x)}; h2[5] = (f32x2v){bflo(w1.y), bfhi(w1.y)}; h2[6] = (f32x2v){bflo(w1.z), bfhi(w1.z)}; h2[7] = (f32x2v){bflo(w1.w), bfhi(w1.w)}; }
        const int e0 = F.idx[(size_t)m * 128 + LANE], e1 = F.idx[(size_t)m * 128 + 64 + LANE];
        const float g0 = F.gw[(size_t)m * 128 + LANE], g1 = F.gw[(size_t)m * 128 + 64 + LANE];
        float aA = 0.f, aB = 0.f;
#pragma unroll 2
        for (int jb = 0; jb < 128; jb += 8) {
            v4u u[8];
#pragma unroll
            for (int k = 0; k < 8; ++k) { const int j = jb + k; const int e = __builtin_amdgcn_readlane(j < 64 ? e0 : e1, j & 63); u[k] = *(const v4u*)(F.u8 + (size_t)e * D + LANE * 16); }
            float d[8];
#pragma unroll
            for (int k = 0; k < 8; ++k) d[k] = dot16_fp8(h2, u[k]);
            float d4[4], d2[2];
#pragma unroll
            for (int i = 0; i < 4; ++i) { const float snd = b0 ? d[2 * i] : d[2 * i + 1], kp = b0 ? d[2 * i + 1] : d[2 * i]; d4[i] = kp + __shfl_xor(snd, 1); }
#pragma unroll
            for (int i = 0; i < 2; ++i) { const float snd = b1 ? d4[2 * i] : d4[2 * i + 1], kp = b1 ? d4[2 * i + 1] : d4[2 * i]; d2[i] = kp + __shfl_xor(snd, 2); }
            float d1; { const float snd = b2 ? d2[0] : d2[1], kp = b2 ? d2[1] : d2[0]; d1 = kp + __shfl_xor(snd, 4); }
            d1 += __shfl_xor(d1, 8); d1 += __shfl_xor(d1, 16); d1 += __shfl_xor(d1, 32);
            const bool mine = (LANE >> 3) == ((jb >> 3) & 7);
            if (jb < 64) aA = mine ? d1 : aA; else aB = mine ? d1 : aB;
        }
        const float wA = g0 * gelu_erf(aA * (1.0f / USCALE)), wB = g1 * gelu_erf(aB * (1.0f / USCALE));
        f32x2v acc[8];
#pragma unroll
        for (int k = 0; k < 8; ++k) acc[k] = (f32x2v){0.f, 0.f};
#pragma unroll 2
        for (int jb = 0; jb < 128; jb += 8) {
            v4u v[8];
#pragma unroll
            for (int k = 0; k < 8; ++k) { const int j = jb + k; const int e = __builtin_amdgcn_readlane(j < 64 ? e0 : e1, j & 63); v[k] = *(const v4u*)(F.v8 + (size_t)e * D + LANE * 16); }
#pragma unroll
            for (int k = 0; k < 8; ++k) { const int j = jb + k;
                const float w = __builtin_bit_cast(float, __builtin_amdgcn_readlane(__builtin_bit_cast(int, j < 64 ? wA : wB), j & 63));
                const f32x2v w2 = (f32x2v){w, w};
#pragma unroll
                for (int q = 0; q < 4; ++q) {
                    const f32x2v lo = __builtin_amdgcn_cvt_pk_f32_fp8((int)v[k][q], false), hi = __builtin_amdgcn_cvt_pk_f32_fp8((int)v[k][q], true);
                    acc[2 * q] = __builtin_elementwise_fma(lo, w2, acc[2 * q]); acc[2 * q + 1] = __builtin_elementwise_fma(hi, w2, acc[2 * q + 1]);
                } }
        }
        float* xr = F.out + (size_t)m * D + LANE * 16; const float* gt = F.mod + b * 6144 + 5120 + LANE * 16;
        f32x4 y[4]; float s = 0.f;
#pragma unroll
        for (int q = 0; q < 4; ++q) {
            const f32x4 xa = *(const f32x4*)(xr + 4 * q), ga = *(const f32x4*)(gt + 4 * q);
            const f32x4 p = (f32x4){acc[2 * q].x, acc[2 * q].y, acc[2 * q + 1].x, acc[2 * q + 1].y} * (1.0f / VSCALE);
            y[q] = xa * ALPHA + (ga + 1.0f) * p; s += (y[q].x + y[q].y) + (y[q].z + y[q].w);
        }
        const float mean = wave_sum(s) * (1.f / D); float s2 = 0.f;
#pragma unroll
        for (int q = 0; q < 4; ++q) { y[q] = y[q] - mean; s2 += (y[q].x * y[q].x + y[q].y * y[q].y) + (y[q].z * y[q].z + y[q].w * y[q].w); }
        const float rstd = 1.f / sqrtf(wave_sum(s2) * (1.f / D) + LN_EPS);
#pragma unroll
        for (int q = 0; q < 4; ++q) *(f32x4*)(xr + 4 * q) = y[q] * rstd * *(const f32x4*)(F.ln2_g + LANE * 16 + 4 * q) + *(const f32x4*)(F.ln2_b + LANE * 16 + 4 * q);
    }
}

struct FnZ {
    bf16* zc; bf16* gates;
    __device__ __forceinline__ void operator()(int row, int col, pg8::f32x4 v0, pg8::f32x4 v1, int pn) const {
        if (pn < 2) { v0 = v0 * C2; v1 = v1 * C2; }
        else if (pn == 4 || pn == 5) { const float f = __builtin_amdgcn_exp2f(__builtin_amdgcn_exp2f(-(float)(((col - ZV) >> 6) + 1)) * LOG2E * (float)(row & 63)); v0 = v0 * f; v1 = v1 * f; }
        else if (pn >= 6 && pn < 10) { v0 = pg8::gelu4(v0); v1 = pg8::gelu4(v1); }
        else if (pn >= 10) { v0 = pg8::sigm4(v0); v1 = pg8::sigm4(v1); }
        bf16* dst = (pn < 10) ? zc + (size_t)row * ZC + col : gates + (size_t)row * GC + (col - ZC);
        *(pg8::u32x4*)dst = pg8::pack8(v0, v1);
    }
};
struct FnUpA {
    bf16* zc; const bf16* gates;
    __device__ __forceinline__ void operator()(int row, int col, pg8::f32x4 v0, pg8::f32x4 v1, int) const {
        pg8::f32x4 g0, g1; pg8::unpack8(*(const pg8::u32x4*)(gates + (size_t)row * GC + col), g0, g1);
        *(pg8::u32x4*)(zc + (size_t)row * ZC + 512 + col) = pg8::pack8(v0 * g0, v1 * g1);
    }
};
struct FnUpB {
    bf16* zc; const bf16* gates;
    __device__ __forceinline__ void operator()(int row, int col, pg8::f32x4 v0, pg8::f32x4 v1, int) const {
        pg8::f32x4 g0, g1, m0, m1; pg8::unpack8(*(const pg8::u32x4*)(gates + (size_t)row * GC + 1024 + col), g0, g1);
        bf16* p = zc + (size_t)row * ZC + 512 + col; pg8::unpack8(*(const pg8::u32x4*)p, m0, m1);
        *(pg8::u32x4*)p = pg8::pack8(m0 + v0 * g0, m1 + v1 * g1);
    }
};
struct FnV1 {
    const float* x; const float* mod; float* out;
    __device__ __forceinline__ void operator()(int row, int col, pg8::f32x4 v0, pg8::f32x4 v1, int) const {
        const int b = row >> 13; const float* gt = mod + b * 6144 + 2048 + col;
        const pg8::f32x4 x0 = *(const pg8::f32x4*)(x + (size_t)row * D + col), x1 = *(const pg8::f32x4*)(x + (size_t)row * D + col + 4);
        const pg8::f32x4 t0 = *(const pg8::f32x4*)gt, t1 = *(const pg8::f32x4*)(gt + 4);
        *(pg8::f32x4*)(out + (size_t)row * D + col) = x0 * ALPHA + (t0 + 1.0f) * v0;
        *(pg8::f32x4*)(out + (size_t)row * D + col + 4) = x1 * ALPHA + (t1 + 1.0f) * v1;
    }
};
struct FnPlain {
    bf16* o; int ldc;
    __device__ __forceinline__ void operator()(int row, int col, pg8::f32x4 v0, pg8::f32x4 v1, int) const { *(pg8::u32x4*)(o + (size_t)row * ldc + col) = pg8::pack8(v0, v1); }
};

constexpr int NPH = 12;
#ifndef MK_PER_PHASE
#define MK_PER_PHASE 0
#endif
struct Args { const float* in[20]; float* out; unsigned char* ws; int ph_lo, ph_hi; };
__global__ void __launch_bounds__(NWAVES * 64, 2) mk_fwd(Args args) {
    extern __shared__ __attribute__((aligned(16))) unsigned char lds[];
    Frame F;
    F.lds = (LAS unsigned char*)lds;
    F.MISC = (volatile LAS unsigned*)(F.lds + MISC_OFF);
    F.wave = __builtin_amdgcn_readfirstlane((int)threadIdx.x >> 6); F.G = gridDim.x;
    unsigned char* ws = args.ws;
    F.ctl = (gu32*)(ws + WS_CTL);
    F.x = args.in[0]; F.c = args.in[1]; F.w_cond = args.in[2]; F.b_cond = args.in[3]; F.w_in = args.in[4]; F.w_attn_up = args.in[5]; F.w_gmlp_up = args.in[6]; F.w_out = args.in[7];
    F.sgu_ln_g = args.in[8]; F.sgu_ln_b = args.in[9]; F.w_spatial = args.in[10]; F.b_spatial = args.in[11]; F.ln1_g = args.in[12]; F.ln1_b = args.in[13]; F.w_peer_q = args.in[14];
    F.sub_keys = args.in[15]; F.peer_u = args.in[16]; F.peer_v = args.in[17]; F.ln2_g = args.in[18]; F.ln2_b = args.in[19];
    F.out = args.out;
    F.mod = (float*)(ws + WS_MOD); F.kmi = (bf16*)(ws + WS_KMEAN); F.ts = (float*)(ws + WS_TS); F.gw = (float*)(ws + WS_GW); F.idx = (int*)(ws + WS_IDX);
    F.win_t = (bf16*)(ws + WS_WIN); F.wa_t = (bf16*)(ws + WS_WA); F.wg_t = (bf16*)(ws + WS_WG); F.wout_t = (bf16*)(ws + WS_WOUT); F.wpq_t = (bf16*)(ws + WS_WPQ);
    F.u8 = ws + WS_U8; F.v8 = ws + WS_V8; F.xn = (bf16*)(ws + WS_XN); F.zc = (bf16*)(ws + WS_ZC); F.pq = (bf16*)(ws + WS_ZC); F.gates = (bf16*)args.out;
    for (int u = threadIdx.x; u < (LDS_BYTES - LDSCTL_OFF) / 4; u += NWAVES * 64) ((LAS unsigned*)(F.lds + LDSCTL_OFF))[u] = 0u;
    __syncthreads();
    const int lo = args.ph_lo, hi = args.ph_hi;
    XcdBarrier bar; bar.bar = (unsigned*)(F.ctl + CW_BAR); bar.x = 0; bar.st = nullptr; bar.wave = F.wave;
    if (hi - lo > 1) bar = xcd_barrier_post((unsigned*)(F.ctl + CW_BAR), F.MISC + 8, F.wave);
#define IN(k) (lo <= (k) && (k) < hi)
#define SEAM(k) do { if (IN(k) && IN((k) + 1)) xcd_barrier(bar); } while (0)

    if (IN(0)) { p0_prologue(F); SEAM(0); }
    if (IN(1)) { p1_modulate(F); SEAM(1); }
    if (IN(2)) {
        pg8::Gemm g{F.xn, F.win_t, M, INC, D, D, D}; pg8::StaticOrder S; S.init(M, INC, F.G, (int)blockIdx.x);
        pg8::EpiFn<FnZ> E{FnZ{F.zc, F.gates}};
        pg8::gemm_phase<pg8::EpiFn<FnZ>, pg8::StaticOrder, true, true>(F.lds, g, S, E, F.wave);
        SEAM(2);
    }
    if (IN(3)) { p3_kmean(F); p3_sgu(F); SEAM(3); }
    if (IN(4)) {
        const attn_body::AttnTensors AT{(const attn_body::bf16*)(F.zc + ZQ), (const attn_body::bf16*)(F.zc + ZK), (const attn_body::bf16*)(F.zc + ZV), (attn_body::bf16*)(F.zc + ZQ)};
        const attn_body::StaticOrder S((int)F.G, (int)blockIdx.x);
        attn_body::attn_phase<attn_body::StaticOrder>((char*)lds, AT, (const unsigned short*)F.kmi, S, F.wave);
        SEAM(4);
    }
    if (IN(5)) {
        { pg8::Gemm g{F.zc + ZQ, F.wa_t, M, D, 512, ZC, 512}; pg8::StaticOrder S; S.init(M, D, F.G, (int)blockIdx.x);
          pg8::EpiFn<FnUpA> E{FnUpA{F.zc, F.gates}};
          pg8::gemm_phase<pg8::EpiFn<FnUpA>, pg8::StaticOrder, true, true>(F.lds, g, S, E, F.wave); }
        VM_WAIT(); __syncthreads();
        { pg8::Gemm g{F.zc + ZGU, F.wg_t, M, D, 512, ZC, 512}; pg8::StaticOrder S; S.init(M, D, F.G, (int)blockIdx.x);
          pg8::EpiFn<FnUpB> E{FnUpB{F.zc, F.gates}};
          pg8::gemm_phase<pg8::EpiFn<FnUpB>, pg8::StaticOrder, true, true>(F.lds, g, S, E, F.wave); }
        SEAM(5);
    }
    if (IN(6)) {
        pg8::Gemm g{F.zc + 512, F.wout_t, M, D, D, ZC, D}; pg8::StaticOrder S; S.init(M, D, F.G, (int)blockIdx.x);
        pg8::EpiFn<FnV1> E{FnV1{F.x, F.mod, F.out}};
        pg8::gemm_phase<pg8::EpiFn<FnV1>, pg8::StaticOrder, true, true>(F.lds, g, S, E, F.wave);
        SEAM(6);
    }
    if (IN(7)) { p7_ln(F); SEAM(7); }
    if (IN(8)) {
        pg8::Gemm g{F.xn, F.wpq_t, M, PQC, D, D, D}; pg8::StaticOrder S; S.init(M, PQC, F.G, (int)blockIdx.x);
        pg8::EpiFn<FnPlain> E{FnPlain{F.pq, PQC}};
        pg8::gemm_phase<pg8::EpiFn<FnPlain>, pg8::StaticOrder, true, true>(F.lds, g, S, E, F.wave);
        SEAM(8);
    }
    if (IN(9)) { p9_topk_simple(F); SEAM(9); }
    if (IN(10)) { p9b_combine(F); SEAM(10); }
    if (IN(11)) { p10_peer(F); }
#undef IN
#undef SEAM
}

extern "C" void kernel_launch(void* const* d_in, const int* in_sizes, int n_in, void* d_out, int out_size, void* d_ws, size_t ws_size, hipStream_t stream) {
    static int grid = 0;
    if (grid == 0) {
        if (n_in != 20 || in_sizes[0] != M * D || out_size != M * D || ws_size < WS_END) { fprintf(stderr, "kernel_launch: unexpected shapes (n_in %d, in0 %d, out %d, ws %zu); nothing launched\n", n_in, n_in > 0 ? in_sizes[0] : -1, out_size, ws_size); grid = -1; return; }
        int dev = 0, cus = 0;
        if (hipGetDevice(&dev) != hipSuccess || hipDeviceGetAttribute(&cus, hipDeviceAttributeMultiprocessorCount, dev) != hipSuccess) { grid = -1; return; }
        if (hipFuncSetAttribute((const void*)mk_fwd, hipFuncAttributeMaxDynamicSharedMemorySize, LDS_BYTES) != hipSuccess) { fprintf(stderr, "kernel_launch: hipFuncSetAttribute failed\n"); grid = -1; return; }
        (void)hipGetLastError();
        grid = cus < 256 ? cus : 256;
    }
    if (grid < 0) return;
    if (hipMemsetAsync((char*)d_ws + WS_CTL, 0, CTL_ZERO_BYTES, stream) != hipSuccess) return;
    Args a{};
    for (int i = 0; i < 20; ++i) a.in[i] = (const float*)d_in[i];
    a.out = (float*)d_out; a.ws = (unsigned char*)d_ws;
#if MK_PER_PHASE
    for (int p = 0; p < NPH; ++p) { a.ph_lo = p; a.ph_hi = p + 1; hipLaunchKernelGGL(mk_fwd, dim3(grid), dim3(NWAVES * 64), LDS_BYTES, stream, a); }
#else
    a.ph_lo = 0; a.ph_hi = NPH; hipLaunchKernelGGL(mk_fwd, dim3(grid), dim3(NWAVES * 64), LDS_BYTES, stream, a);
#endif
}
```

```cpp
#include <hip/hip_runtime.h>
#include <cstdio>
#include <cstdint>
#include <cmath>
__device__ __forceinline__ int mk_lane_id() { int l; asm volatile("v_mbcnt_lo_u32_b32 %0, -1, 0\n\tv_mbcnt_hi_u32_b32 %0, -1, %0" : "=v"(l)); return l; }
namespace pg8 {
#define PG8_LAS __attribute__((address_space(3)))
typedef unsigned short bf16_t;
typedef short bf16x8 __attribute__((ext_vector_type(8)));
typedef float f32x4 __attribute__((ext_vector_type(4)));
typedef unsigned u32x4 __attribute__((ext_vector_type(4)));
constexpr int BM = 256, BK = 64, HALF = 128, HTB = HALF * BK * 2  , STAGE_BYTES = 8 * HTB, NXCD = 8, WGM = 8;

__host__ __device__ __forceinline__ int lds_byte(int r, int c) { const int st = (r >> 4) * 2 + (c >> 5), rr = r & 15, cc = c & 31, ob = rr * 64 + cc * 2; return st * 1024 + (ob ^ (((ob >> 9) & 1) << 5)); }
__host__ __device__ __forceinline__ void stage_rc(int b, int& R, int& C) { const int st = b / 1024, sb = b % 1024, swz = sb ^ (((sb >> 9) & 1) << 5); R = (st >> 1) * 16 + swz / 64; C = (st & 1) * 32 + (swz % 64) / 2; }
__host__ __device__ __forceinline__ int perm32(int rho) { const int n = rho >> 4, i = rho & 15; return 8 * (i >> 2) + 4 * n + (i & 3); }

struct Unit { int pm, pn; };
struct Gemm { const bf16_t* A; const bf16_t* Bt; int M, N, K, lda, ldb; };

struct StaticOrder {
    int nM, nN, nwg, G, c;
    __host__ __device__ void init(int M, int N, int G_, int c_) { nM = M / BM; nN = N / BM; nwg = nM * nN; G = G_; c = c_; }
    __host__ __device__ bool next(int i, Unit& u) const {
        const long L = (long)i * G + c; if (L >= nwg) return false;
        int wgid = (int)L; { const int q = nwg / NXCD, r = nwg % NXCD, xcd = wgid % NXCD, off = wgid / NXCD; wgid = (xcd < r ? xcd * (q + 1) : r * (q + 1) + (xcd - r) * q) + off; }
        const int nig = WGM * nN, gid = wgid / nig, fm = gid * WGM, gsz = (nM - fm) < WGM ? (nM - fm) : WGM;
        u.pm = fm + ((wgid % nig) % gsz); u.pn = (wgid % nig) / gsz; return true;
    }
    __device__ __forceinline__ void a_ready(const Unit&) const {}
    __device__ __forceinline__ void done(const Unit&) const {}
};

__device__ __forceinline__ unsigned cvt_pk_bf16(float lo, float hi) { unsigned r; asm volatile("v_cvt_pk_bf16_f32 %0, %1, %2" : "=v"(r) : "v"(lo), "v"(hi)); return r; }
typedef float f32x2 __attribute__((ext_vector_type(2)));
__device__ __forceinline__ f32x2 gelu_pk(f32x2 v) {
    const f32x2 av = __builtin_elementwise_abs(v), d = av * 0.2316418882f + 1.0f;
    f32x2 t; t.x = __builtin_amdgcn_rcpf(d.x); t.y = __builtin_amdgcn_rcpf(d.y);
    f32x2 q = t * 0.5307027145f + (-0.7265760135f); q = q * t + 0.7107068705f; q = q * t + (-0.142248368f); q = q * t + 0.127414796f; q = q * t;
    const f32x2 s = (v * v) * (-0.72134752044f);
    f32x2 e; e.x = __builtin_amdgcn_exp2f(s.x); e.y = __builtin_amdgcn_exp2f(s.y);
    const f32x2 m = v * (q * e), r = v - m;
    f32x2 o; o.x = v.x < 0.f ? m.x : r.x; o.y = v.y < 0.f ? m.y : r.y; return o;
}

template <class Fn> struct EpiFn {
    static constexpr bool PERM = true, AFTER_DRAIN = false; Fn fn;
    __device__ __forceinline__ void operator()(const f32x4 (&acc)[2][2][4][2], const Unit& u, int wr, int wc, int fr, int fq) const {
        const int row0 = u.pm * BM + wr * 64 + fr, col0 = u.pn * BM + wc * 32 + 8 * fq;
#pragma unroll
        for (int ai = 0; ai < 2; ++ai)
#pragma unroll
            for (int m = 0; m < 4; ++m)
#pragma unroll
                for (int bj = 0; bj < 2; ++bj) fn(row0 + ai * HALF + m * 16, col0 + bj * HALF, acc[ai][bj][m][0], acc[ai][bj][m][1], u.pn);
    }
};
__device__ __forceinline__ u32x4 pack8(f32x4 v0, f32x4 v1) { u32x4 w; w.x = cvt_pk_bf16(v0[0], v0[1]); w.y = cvt_pk_bf16(v0[2], v0[3]); w.z = cvt_pk_bf16(v1[0], v1[1]); w.w = cvt_pk_bf16(v1[2], v1[3]); return w; }
__device__ __forceinline__ f32x4 gelu4(f32x4 v) { f32x2 a = gelu_pk((f32x2){v[0], v[1]}), b = gelu_pk((f32x2){v[2], v[3]}); return (f32x4){a.x, a.y, b.x, b.y}; }
__device__ __forceinline__ float sigm1(float x) { return __builtin_amdgcn_rcpf(1.0f + __builtin_amdgcn_exp2f(-1.4426950408889634f * x)); }
__device__ __forceinline__ f32x4 sigm4(f32x4 v) { return (f32x4){sigm1(v[0]), sigm1(v[1]), sigm1(v[2]), sigm1(v[3])}; }
__device__ __forceinline__ void unpack8(u32x4 w, f32x4& a, f32x4& b) {
    a = (f32x4){__uint_as_float(w.x << 16), __uint_as_float(w.x & 0xffff0000u), __uint_as_float(w.y << 16), __uint_as_float(w.y & 0xffff0000u)};
    b = (f32x4){__uint_as_float(w.z << 16), __uint_as_float(w.z & 0xffff0000u), __uint_as_float(w.w << 16), __uint_as_float(w.w & 0xffff0000u)};
}
template <class Epi, class Sched, bool ALIGN_EPI = false, bool SP2 = false>
__device__ __forceinline__ void gemm_phase(PG8_LAS unsigned char* lds, const Gemm g, const Sched& S, const Epi& E, const int wave_id  ) {
    const int wid = wave_id, lane = mk_lane_id(), tid = wid * 64 + lane, wr = wid >> 2, wc = wid & 3, fr = lane & 15, fq = lane >> 4;
    const int K = g.K, nt = K / BK;
    unsigned voffA[2], voffB[2];
#pragma unroll
    for (int i = 0; i < 2; ++i) { int R, C; stage_rc(tid * 16 + i * 8192, R, C); const int Rb = Epi::PERM ? ((R & ~31) + perm32(R & 31)) : R;
        voffA[i] = (unsigned)(R * g.lda + C) * 2u; voffB[i] = (unsigned)(Rb * g.ldb + C) * 2u; }
    const size_t kstep = (size_t)(BK * 2);
    const size_t hstepA = (size_t)HALF * g.lda * 2, hstepB = (size_t)HALF * g.ldb * 2;
    const size_t tstepA = 2 * hstepA, tstepB = 2 * hstepB;
    const unsigned ldsw = (unsigned)wid * 1024u;
    const int aoff = lds_byte(wr * 64 + fr, fq * 8), boff = lds_byte(wc * 32 + fr, fq * 8);
#define PG8_SA(b, h) (((b) * 2 + (h)) * HTB)
#define PG8_SB(b, h) ((4 + (b) * 2 + (h)) * HTB)
#define PG8_STAGE(bufoff, gbase, voff) do { _Pragma("unroll") for (int _i = 0; _i < 2; ++_i) \
        __builtin_amdgcn_global_load_lds((const unsigned*)((const char*)(gbase) + (voff)[_i]), (PG8_LAS unsigned*)(lds + (bufoff) + ldsw + _i * 8192), 16, 0, 0); } while (0)
#define PG8_LDA(dst, b, h) do { _Pragma("unroll") for (int m = 0; m < 4; ++m) _Pragma("unroll") for (int k = 0; k < 2; ++k) dst[m][k] = *(const PG8_LAS bf16x8*)(lds + PG8_SA(b, h) + aoff + m * 2048 + k * 1024); } while (0)
#define PG8_LDB(dst, b, h) do { _Pragma("unroll") for (int n = 0; n < 2; ++n) _Pragma("unroll") for (int k = 0; k < 2; ++k) dst[n][k] = *(const PG8_LAS bf16x8*)(lds + PG8_SB(b, h) + boff + n * 2048 + k * 1024); } while (0)
#define PG8_MMA(ai, bj, At, Bt) do { __builtin_amdgcn_s_setprio(1); _Pragma("unroll") for (int m = 0; m < 4; ++m) _Pragma("unroll") for (int n = 0; n < 2; ++n) _Pragma("unroll") for (int k = 0; k < 2; ++k) \
        acc[ai][bj][m][n] = __builtin_amdgcn_mfma_f32_16x16x32_bf16(Bt[n][k], At[m][k], acc[ai][bj][m][n], 0, 0, 0); __builtin_amdgcn_s_setprio(0); } while (0)
#define PG8_WAIT_V(n) asm volatile("s_waitcnt vmcnt(" #n ")" ::: "memory")
#define PG8_WAIT_L(n) asm volatile("s_waitcnt lgkmcnt(" #n ")" ::: "memory")
#define PG8_BAR __builtin_amdgcn_s_barrier()
#define PG8_SCHED __builtin_amdgcn_sched_barrier(0)
    Unit cur, nxt; int ui = 0;
    if (!S.next(0, cur)) return;
    f32x4 acc[2][2][4][2];
#pragma unroll
    for (int a = 0; a < 2; ++a)
#pragma unroll
        for (int b = 0; b < 2; ++b)
#pragma unroll
            for (int m = 0; m < 4; ++m)
#pragma unroll
                for (int n = 0; n < 2; ++n) acc[a][b][m][n] = (f32x4){0.f, 0.f, 0.f, 0.f};
    bf16x8 At[4][2], B0[2][2], B1[2][2];
    const char* cA = (const char*)g.A + (size_t)cur.pm * tstepA; const char* cB = (const char*)g.Bt + (size_t)cur.pn * tstepB;
    S.a_ready(cur);
    if constexpr (SP2) {
        PG8_STAGE(PG8_SB(0, 0), cB, voffB); PG8_STAGE(PG8_SB(0, 1), cB + hstepB, voffB); PG8_STAGE(PG8_SA(0, 0), cA, voffA); PG8_STAGE(PG8_SA(0, 1), cA + hstepA, voffA);
        if (wr == 1) PG8_BAR;
        PG8_WAIT_V(2); PG8_BAR;
        PG8_STAGE(PG8_SB(1, 0), cB + kstep, voffB); PG8_STAGE(PG8_SA(1, 0), cA + kstep, voffA); PG8_STAGE(PG8_SB(1, 1), cB + hstepB + kstep, voffB);
        PG8_WAIT_V(6); PG8_BAR;
    } else {
        PG8_STAGE(PG8_SB(0, 0), cB, voffB); PG8_STAGE(PG8_SA(0, 0), cA, voffA); PG8_STAGE(PG8_SB(0, 1), cB + hstepB, voffB); PG8_STAGE(PG8_SA(0, 1), cA + hstepA, voffA);
        if (wr == 1) PG8_BAR;
        PG8_WAIT_V(4); PG8_BAR;
        PG8_STAGE(PG8_SB(1, 0), cB + kstep, voffB); PG8_STAGE(PG8_SA(1, 0), cA + kstep, voffA); PG8_STAGE(PG8_SB(1, 1), cB + hstepB + kstep, voffB);
        PG8_WAIT_V(6); PG8_BAR;
    }
    for (;;) {
        const bool has_next = S.next(ui + 1, nxt);
        const char* nA = has_next ? (const char*)g.A + (size_t)nxt.pm * tstepA : cA; const char* nB = has_next ? (const char*)g.Bt + (size_t)nxt.pn * tstepB : cB;
        for (int t = 0; t < nt; t += 2) {
            const bool last = (t == nt - 2);
            const char* a1 = cA + (size_t)(t + 1) * kstep;
            const char* a2 = last ? nA : cA + (size_t)(t + 2) * kstep; const char* b2 = last ? nB : cB + (size_t)(t + 2) * kstep;
            const char* a3 = a2 + kstep; const char* b3 = b2 + kstep;
            if (last && has_next) S.a_ready(nxt);
            if constexpr (SP2) {
            PG8_LDB(B0, 0, 0); PG8_LDB(B1, 0, 1); PG8_SCHED; PG8_LDA(At, 0, 0); PG8_STAGE(PG8_SA(1, 1), a1 + hstepA, voffA);
            PG8_WAIT_V(8); PG8_WAIT_L(0); PG8_BAR; PG8_MMA(0, 0, At, B0); PG8_MMA(0, 1, At, B1); PG8_BAR; PG8_SCHED;
            PG8_LDA(At, 0, 1); PG8_STAGE(PG8_SB(0, 0), b2, voffB); PG8_STAGE(PG8_SB(0, 1), b2 + hstepB, voffB); PG8_STAGE(PG8_SA(0, 0), a2, voffA);
            PG8_WAIT_V(8); PG8_WAIT_L(0); PG8_BAR; PG8_MMA(1, 0, At, B0); PG8_MMA(1, 1, At, B1); PG8_BAR; PG8_SCHED;
            PG8_LDB(B0, 1, 0); PG8_LDB(B1, 1, 1); PG8_SCHED; PG8_LDA(At, 1, 0); PG8_STAGE(PG8_SA(0, 1), a2 + hstepA, voffA);
            PG8_WAIT_V(8); PG8_WAIT_L(0); PG8_BAR; PG8_MMA(0, 0, At, B0); PG8_MMA(0, 1, At, B1); PG8_BAR; PG8_SCHED;
            PG8_LDA(At, 1, 1); PG8_STAGE(PG8_SB(1, 0), b3, voffB); PG8_STAGE(PG8_SB(1, 1), b3 + hstepB, voffB); PG8_STAGE(PG8_SA(1, 0), a3, voffA);
            PG8_WAIT_V(8); PG8_WAIT_L(0); PG8_BAR; PG8_MMA(1, 0, At, B0); PG8_MMA(1, 1, At, B1); PG8_BAR; PG8_SCHED;
            } else {
            PG8_LDB(B0, 0, 0); PG8_SCHED; PG8_LDA(At, 0, 0); PG8_STAGE(PG8_SA(1, 1), a1 + hstepA, voffA);
            PG8_WAIT_L(8); PG8_BAR; PG8_WAIT_L(0); PG8_MMA(0, 0, At, B0); PG8_BAR; PG8_SCHED;
            PG8_LDB(B1, 0, 1); PG8_STAGE(PG8_SB(0, 0), b2, voffB);
            PG8_BAR; PG8_WAIT_L(0); PG8_MMA(0, 1, At, B1); PG8_BAR;
            PG8_LDA(At, 0, 1); PG8_STAGE(PG8_SA(0, 0), a2, voffA);
            PG8_BAR; PG8_WAIT_L(0); PG8_MMA(1, 0, At, B0); PG8_BAR; PG8_SCHED;
            PG8_STAGE(PG8_SB(0, 1), b2 + hstepB, voffB);
            PG8_WAIT_V(6); PG8_BAR; PG8_MMA(1, 1, At, B1); PG8_BAR;
            PG8_LDB(B0, 1, 0); PG8_SCHED; PG8_LDA(At, 1, 0); PG8_STAGE(PG8_SA(0, 1), a2 + hstepA, voffA);
            PG8_WAIT_L(8); PG8_BAR; PG8_WAIT_L(0); PG8_MMA(0, 0, At, B0); PG8_BAR; PG8_SCHED;
            PG8_LDB(B1, 1, 1); PG8_STAGE(PG8_SB(1, 0), b3, voffB);
            PG8_BAR; PG8_WAIT_L(0); PG8_MMA(0, 1, At, B1); PG8_BAR;
            PG8_LDA(At, 1, 1); PG8_STAGE(PG8_SA(1, 0), a3, voffA);
            PG8_BAR; PG8_WAIT_L(0); PG8_MMA(1, 0, At, B0); PG8_BAR; PG8_SCHED;
            PG8_STAGE(PG8_SB(1, 1), b3 + hstepB, voffB);
            PG8_WAIT_V(6); PG8_BAR; PG8_MMA(1, 1, At, B1); PG8_BAR;
            }
        }
        if constexpr (ALIGN_EPI) { if (wr == 0) PG8_BAR; }
        if constexpr (!Epi::AFTER_DRAIN) { E(acc, cur, wr, wc, fr, fq); S.done(cur); }
        if (!has_next) break;
#pragma unroll
        for (int a = 0; a < 2; ++a)
#pragma unroll
            for (int b = 0; b < 2; ++b)
#pragma unroll
                for (int m = 0; m < 4; ++m)
#pragma unroll
                    for (int n = 0; n < 2; ++n) acc[a][b][m][n] = (f32x4){0.f, 0.f, 0.f, 0.f};
        cur = nxt; cA = nA; cB = nB; ++ui;
        if constexpr (ALIGN_EPI) { if (wr == 1) PG8_BAR; }
    }
    PG8_WAIT_V(0);
    if constexpr (!ALIGN_EPI) { if (wr == 0) PG8_BAR; }
    PG8_BAR;
    if constexpr (Epi::AFTER_DRAIN) { E.fused(acc, cur, wr, wc, fr, fq, lds, wid, lane); S.done(cur); }
#undef PG8_SA
#undef PG8_SB
#undef PG8_STAGE
#undef PG8_LDA
#undef PG8_LDB
#undef PG8_MMA
#undef PG8_WAIT_V
#undef PG8_WAIT_L
#undef PG8_BAR
#undef PG8_SCHED
}
}
#define GAS __attribute__((address_space(1)))
#define LAS __attribute__((address_space(3)))
typedef unsigned short bf16;
typedef unsigned v4u __attribute__((ext_vector_type(4)));
typedef float f32x4 __attribute__((ext_vector_type(4)));
typedef short bf16x8 __attribute__((ext_vector_type(8)));
typedef GAS unsigned gu32;
typedef GAS unsigned long long gu64;
#define RLX_AGENT __ATOMIC_RELAXED, __HIP_MEMORY_SCOPE_AGENT
#define LDS_WAIT() asm volatile("s_waitcnt lgkmcnt(0)" ::: "memory")
#define VM_WAIT() asm volatile("s_waitcnt vmcnt(0)" ::: "memory")
__device__ __forceinline__ unsigned long long rt() { return __builtin_amdgcn_s_memrealtime(); }
__device__ __forceinline__ unsigned f2bf(float f) { unsigned u = __builtin_bit_cast(unsigned, f); return (u + 0x7fffu + ((u >> 16) & 1u)) >> 16; }
__device__ __forceinline__ unsigned pk2(float lo, float hi) { return f2bf(lo) | (f2bf(hi) << 16); }

#define XB_TMO      128
#define XB_XCNT(j)  (256  + 64 * (j))
#define XB_XSUB(j)  (1280 + 64 * (j))
#define XB_XGEN(j)  (2304 + 64 * (j))
#define XB_TOP      3328
#define XB_TOPGEN   3392
#define XCD_BAR_WORDS 3456
#define XB_SPIN_CAP (1u << 18)

__device__ __forceinline__ unsigned xb_ld(unsigned* p)              { return __hip_atomic_load(p, __ATOMIC_RELAXED, __HIP_MEMORY_SCOPE_AGENT); }
__device__ __forceinline__ unsigned xb_add(unsigned* p, unsigned v) { return __hip_atomic_fetch_add(p, v, __ATOMIC_RELAXED, __HIP_MEMORY_SCOPE_AGENT); }
__device__ __forceinline__ unsigned xb_xcc_id() { return (unsigned)__builtin_amdgcn_s_getreg((3 << 11) | 20) & 0xFu; }
#define XB_SPIN(cond, bar) do { unsigned _sp = 0; while (cond) { __builtin_amdgcn_s_sleep(1); \
    if ((++_sp & 255u) == 0u) { if (xb_ld(&(bar)[XB_TMO])) break; if (_sp > XB_SPIN_CAP) { atomicAdd(&(bar)[XB_TMO], 1u); break; } } } } while (0)

struct XcdBarrier {
    unsigned* bar; unsigned x; int wave;
    volatile LAS unsigned* st;
};

__device__ __forceinline__ XcdBarrier xcd_barrier_post(unsigned* bar, volatile LAS unsigned* st, int wave) {
    XcdBarrier b; b.bar = bar; b.x = xb_xcc_id(); b.st = st; b.wave = wave;
    if (wave == 0 && mk_lane_id() == 0) (void)xb_add(&bar[XB_XCNT(b.x)], 1u);
    return b;
}
__device__ __forceinline__ void xcd_barrier_complete(unsigned* bar, unsigned x, unsigned& nloc, unsigned& nx) {
    const unsigned G = gridDim.x * gridDim.y * gridDim.z;
    unsigned sum, cnt, mine, sp = 0u;
    for (;;) {
        sum = 0u; cnt = 0u; mine = 0u;
#pragma unroll
        for (unsigned j = 0; j < 16; ++j) { const unsigned c = xb_ld(&bar[XB_XCNT(j)]); sum += c; cnt += (c > 0u) ? 1u : 0u; mine = (j == x) ? c : mine; }
        if (sum == G) break;
        __builtin_amdgcn_s_sleep(1);
        if ((++sp & 255u) == 0u) { if (xb_ld(&bar[XB_TMO])) break; if (sp > XB_SPIN_CAP) { atomicAdd(&bar[XB_TMO], 1u); break; } }
    }
    nloc = mine > 0u ? mine : 1u; nx = cnt > 0u ? cnt : 1u;
}

__device__ __forceinline__ void xcd_barrier(const XcdBarrier& b) {
    asm volatile("s_waitcnt vmcnt(0)" ::: "memory");
    __syncthreads();
    if (b.wave == 0 && mk_lane_id() == 0) {
        unsigned* bar = b.bar;
        __builtin_amdgcn_s_waitcnt(0);
        unsigned nloc = b.st[0], nx = b.st[1];
        if (nloc == 0u) { xcd_barrier_complete(bar, b.x, nloc, nx); b.st[0] = nloc; b.st[1] = nx; }
        const unsigned old = xb_add(&bar[XB_XSUB(b.x)], 1u);
        const unsigned gen = old / nloc;
        if (old + 1u == (gen + 1u) * nloc) {
            __builtin_amdgcn_fence(__ATOMIC_RELEASE, "agent");
            asm volatile("s_waitcnt vmcnt(0)" ::: "memory");
            const unsigned og = xb_add(&bar[XB_TOP], 1u);
            const unsigned tg = og / nx;
            if (og + 1u == (tg + 1u) * nx) xb_add(&bar[XB_TOPGEN], 1u);
            else XB_SPIN(xb_ld(&bar[XB_TOPGEN]) == tg, bar);
            __builtin_amdgcn_fence(__ATOMIC_ACQUIRE, "agent");
            xb_add(&bar[XB_XGEN(b.x)], 1u);
            asm volatile("s_waitcnt vmcnt(0)" ::: "memory");
        } else {
            XB_SPIN(xb_ld(&bar[XB_XGEN(b.x)]) == gen, bar);
            __builtin_amdgcn_fence(__ATOMIC_ACQUIRE, "agent");
            asm volatile("s_waitcnt vmcnt(0)" ::: "memory");
        }
    }
    __syncthreads();
}
#include <hip/hip_bf16.h>
#include <cmath>
namespace attn_body {
using bf16=__hip_bfloat16;
using bf16x8=__attribute__((ext_vector_type(8)))short;
using s16x4=__attribute__((ext_vector_type(4)))short;
using f32x16=__attribute__((ext_vector_type(16)))float;
using u32x4=__attribute__((ext_vector_type(4)))unsigned;
constexpr int BATCH=2,NHEAD=8,SEQ=8192,D=64,DM=2560;
constexpr int NW=8,QBLK=32,QB=QBLK*NW,KVBLK=64,NQB=SEQ/QB;
constexpr int ATTN_PITCH=DM, ATTN_UNIT_ROWS=QB;
__device__ __forceinline__ int crow(int r,int hi){return (r&3)+8*(r>>2)+4*hi;}
#define SBAR() __builtin_amdgcn_sched_barrier(0)
__device__ __forceinline__ void cmask(f32x16&p0,f32x16&p1,int jb,int qrel,int hi){
  const float NEG=-INFINITY; int kb=64*jb+4*hi;
  #pragma unroll
  for(int r=0;r<16;++r){int kv=kb+(r&3)+8*(r>>2); if(kv>qrel)p0[r]=NEG; if(kv+32>qrel)p1[r]=NEG;}
}

__device__ __forceinline__ float uni_f(float v){ float r; asm volatile("s_nop 1\n\tv_readfirstlane_b32 %0, %1\n\ts_nop 3" : "=s"(r) : "v"(v)); return r; }
constexpr int NSLOT=3, SLOTB=8192;
constexpr int LDS_K=0, LDS_V=NSLOT*SLOTB, LDS_WS=2*NSLOT*SLOTB, LDS_OST=LDS_WS+NW*64*4, LDS_BYTES=LDS_OST+NW*4096, LDS_KMI=86016  ;
constexpr float C2=0.125f*1.4426950408889634f;
__device__ __forceinline__ void glds16(const void*gsrc,unsigned lds_dst){unsigned keep;
  asm volatile("s_mov_b32 %0, m0\n\ts_mov_b32 m0, %2\n\ts_nop 0\n\tglobal_load_lds_dwordx4 %1, off\n\ts_mov_b32 m0, %0":"=&s"(keep):"v"(gsrc),"s"(lds_dst):"memory");}
__device__ __forceinline__ float max3f(float a,float b,float c){float r;asm("v_max3_f32 %0, %1, %2, %3":"=v"(r):"v"(a),"v"(b),"v"(c));return r;}
__device__ __forceinline__ float max2f(float a,float b){float r;asm("v_max_f32_e32 %0, %1, %2":"=v"(r):"v"(a),"v"(b));return r;}
__device__ __forceinline__ float fadd_s(float a,float b){float r;asm("v_add_f32_e32 %0, %1, %2":"=v"(r):"v"(a),"v"(b));return r;}
__device__ __forceinline__ float fsub_s(float a,float b){float r;asm("v_sub_f32_e32 %0, %1, %2":"=v"(r):"v"(a),"v"(b));return r;}
typedef float f32x2_t __attribute__((ext_vector_type(2))); typedef __bf16 bf16x2_t __attribute__((ext_vector_type(2)));
__device__ __forceinline__ unsigned cvtpk_s(float lo,float hi){f32x2_t v={lo,hi};bf16x2_t b=__builtin_convertvector(v,bf16x2_t);return __builtin_bit_cast(unsigned,b);}
#define WAIT_BAR(N) asm volatile("s_waitcnt vmcnt(" #N ") lgkmcnt(0)\n\ts_barrier":::"memory")

__device__ __forceinline__ void qkt(f32x16&p0,f32x16&p1,const char*Kslot,const bf16x8*qr,const f32x16&negm,int r32,int hi){
  const char*kb=Kslot+hi*1024+r32*16;
  #pragma unroll
  for(int d0=0;d0<4;++d0){
    const bf16x8 b0=*reinterpret_cast<const bf16x8*>(kb+d0*2048);
    const bf16x8 b1=*reinterpret_cast<const bf16x8*>(kb+d0*2048+512);
    if(d0==0){p0=__builtin_amdgcn_mfma_f32_32x32x16_bf16(b0,qr[0],negm,0,0,0);p1=__builtin_amdgcn_mfma_f32_32x32x16_bf16(b1,qr[0],negm,0,0,0);}
    else{p0=__builtin_amdgcn_mfma_f32_32x32x16_bf16(b0,qr[d0],p0,0,0,0);p1=__builtin_amdgcn_mfma_f32_32x32x16_bf16(b1,qr[d0],p1,0,0,0);}}
}
typedef __attribute__((address_space(3))) const char* lds_cptr;
typedef short v4i16_t __attribute__((ext_vector_type(4)));
__device__ __forceinline__ void kload8(bf16x8*kf,lds_cptr kp){
  kf[0]=*(const __attribute__((address_space(3))) bf16x8*)(kp);      kf[1]=*(const __attribute__((address_space(3))) bf16x8*)(kp+512);
  kf[2]=*(const __attribute__((address_space(3))) bf16x8*)(kp+2048); kf[3]=*(const __attribute__((address_space(3))) bf16x8*)(kp+2560);
  kf[4]=*(const __attribute__((address_space(3))) bf16x8*)(kp+4096); kf[5]=*(const __attribute__((address_space(3))) bf16x8*)(kp+4608);
  kf[6]=*(const __attribute__((address_space(3))) bf16x8*)(kp+6144); kf[7]=*(const __attribute__((address_space(3))) bf16x8*)(kp+6656);
}
__device__ __forceinline__ void kload2(bf16x8*kf,lds_cptr kp,int j){ kf[2*j]=*(const __attribute__((address_space(3))) bf16x8*)(kp+j*2048); kf[2*j+1]=*(const __attribute__((address_space(3))) bf16x8*)(kp+j*2048+512); }
__device__ __forceinline__ s16x4 vtr(lds_cptr p){ return __builtin_bit_cast(s16x4,__builtin_amdgcn_ds_read_tr16_b64_v4i16((__attribute__((address_space(3))) v4i16_t*)p)); }
__device__ __forceinline__ float rowmax(const f32x16&p0,const f32x16&p1){
  float a=max3f(p0[0],p0[1],p1[0]),b=max3f(p0[2],p0[3],p1[1]);a=max3f(a,p1[2],p1[3]);
  #pragma unroll
  for(int r=4;r<16;r+=4){a=max3f(a,p0[r],p0[r+1]);b=max3f(b,p0[r+2],p0[r+3]);a=max3f(a,p1[r],p1[r+1]);b=max3f(b,p1[r+2],p1[r+3]);}
  const float m=max2f(a,b);
  auto rr=__builtin_amdgcn_permlane32_swap(__float_as_uint(m),__float_as_uint(m),false,false);
  return max2f(__uint_as_float(rr[0]),__uint_as_float(rr[1]));
}
__device__ __forceinline__ void pv(f32x16*o,int vb,bf16x8 pa0,bf16x8 pa1,bf16x8 pa2,bf16x8 pa3){
  #pragma unroll
  for(int d0=0;d0<2;++d0){s16x4 lo[4],hi[4];
    #pragma unroll
    for(int ks=0;ks<4;++ks){
      asm volatile("ds_read_b64_tr_b16 %0,%1 offset:%c2":"=&v"(lo[ks]):"v"(vb),"i"(d0*4096+ks*1024):"memory");
      asm volatile("ds_read_b64_tr_b16 %0,%1 offset:%c2":"=&v"(hi[ks]):"v"(vb),"i"(d0*4096+ks*1024+512):"memory");}
    asm volatile("s_waitcnt lgkmcnt(0)":::"memory");SBAR();
    #define PK(k) (bf16x8){lo[k][0],lo[k][1],lo[k][2],lo[k][3],hi[k][0],hi[k][1],hi[k][2],hi[k][3]}
    o[d0]=__builtin_amdgcn_mfma_f32_32x32x16_bf16(pa0,PK(0),o[d0],0,0,0);
    o[d0]=__builtin_amdgcn_mfma_f32_32x32x16_bf16(pa1,PK(1),o[d0],0,0,0);
    o[d0]=__builtin_amdgcn_mfma_f32_32x32x16_bf16(pa2,PK(2),o[d0],0,0,0);
    o[d0]=__builtin_amdgcn_mfma_f32_32x32x16_bf16(pa3,PK(3),o[d0],0,0,0);
    #undef PK
  }
}

#ifndef ATTN_STORE16
#define ATTN_STORE16(p,v) (*(u32x4*)(p)=(v))
#endif
template<int THRL> __device__ __forceinline__ void attn_unit(int b,int h,int qb,const bf16*Q,const bf16*__restrict__ K,const bf16*__restrict__ V,bf16*O,const unsigned short*kmi,char*shm,const int wave_id){
  const int wid=wave_id,lane=mk_lane_id(),tid=wid*64+lane,r32=lane&31,hi=lane>>5;
  const long rowbase=(long)b*SEQ; const int q0=qb*QB;
  const bf16*Qw=Q+(rowbase+q0+wid*QBLK)*DM+h*D;
  const bf16*Kh=K+rowbase*DM+h*D,*Vh=V+rowbase*DM+h*D;
  const unsigned lds0=(unsigned)(uintptr_t)shm;
  float*wsf=(float*)(shm+LDS_WS)+wid*64;
  const bf16*ksrc=Kh+(long)lane*DM+wid*8;
  const bf16*vsrc=Vh+(long)(16*(wid&3)+(lane>>2))*DM+(wid>>2)*32+(lane&3)*8;
  const unsigned kdst=lds0+LDS_K+wid*1024, vdst=lds0+LDS_V+wid*1024;
  #define DMA_K(t,slot) glds16(ksrc+(long)(t)*KVBLK*DM,(unsigned)__builtin_amdgcn_readfirstlane(kdst+(slot)))
  #define DMA_V(t,slot) glds16(vsrc+(long)(t)*KVBLK*DM,(unsigned)__builtin_amdgcn_readfirstlane(vdst+(slot)))
  const int vb0=(int)(lds0+LDS_V)+((lane>>4)&1)*32+(lane&3)*8+(4*hi+((lane&15)>>2))*64;
  const char*Kbase=shm+LDS_K; bf16x8 kf[8];
  const lds_cptr shm3=(lds_cptr)shm; const lds_cptr kp0=shm3+LDS_K+hi*1024+r32*16; const lds_cptr vp0=shm3+LDS_V+((lane>>4)&1)*32+(lane&3)*8+(4*hi+((lane&15)>>2))*64;
  const int NT=(q0+QB)/KVBLK;
  DMA_K(0,0);DMA_V(0,0);DMA_K(1,SLOTB);
  bf16x8 qr[4];
  #pragma unroll
  for(int d0=0;d0<4;++d0)qr[d0]=*reinterpret_cast<const bf16x8*>(&Qw[(long)r32*DM+d0*16+hi*8]);
  if(tid<256)*(u32x4*)(shm+LDS_KMI+tid*16)=*(const u32x4*)(kmi+tid*8);
  const float sl=__builtin_amdgcn_exp2f(-(float)(h+1))*1.4426950408889634f;
  #define UNI(x) uni_f((float)(x))
  const float W41=UNI(__builtin_amdgcn_exp2f(sl)),W42=UNI(__builtin_amdgcn_exp2f(2.f*sl)),W43=UNI(__builtin_amdgcn_exp2f(3.f*sl));
  const float W81=UNI(__builtin_amdgcn_exp2f(8.f*sl)),W82=UNI(__builtin_amdgcn_exp2f(16.f*sl)),W83=UNI(__builtin_amdgcn_exp2f(24.f*sl));
  const float E32=UNI(__builtin_amdgcn_exp2f(32.f*sl)),sl64=UNI(64.f*sl),E4=UNI(__builtin_amdgcn_exp2f(4.f*sl));
  const float rE32=UNI(__builtin_amdgcn_exp2f(-32.f*sl));
  unsigned mask=0u;
  const int qrel=wid*QBLK+r32;
  #define CMASK(P0,P1,t) do{int jb_=(t)-(NT-4); if(jb_>=0)cmask(P0,P1,jb_,qrel,hi);}while(0)
  bool resc=false;
  #define SETNEG(t) do{ const bool sel_=((t)>=NT-4)||(((mask>>((t)>>2))&1u)!=0u); const float v_=sel_?nm:-INFINITY; \
    _Pragma("unroll") for(int r=0;r<16;++r)negm[r]=v_; asm volatile("":"+v"(negm)); }while(0)
  #define RESC() do{ if(resc){ asm volatile("s_waitcnt lgkmcnt(0)":::"memory"); \
      _Pragma("unroll") for(int d_=0;d_<2;++d_) _Pragma("unroll") for(int r=0;r<16;++r)o[d_][r]*=wsf[crow(r,hi)]; } }while(0)
  f32x16 pA0,pA1,pB0,pB1;
  int sl_prev=0,sl_cur=0,sl_next=SLOTB;
  #define ROT() do{sl_prev=sl_cur;sl_cur=sl_next;sl_next=(sl_next==(NSLOT-1)*SLOTB)?0:sl_next+SLOTB;}while(0)
  DMA_K(2,2*SLOTB);
  WAIT_BAR(3);
  float z0_; asm volatile("v_mov_b32 %0, 0":"=v"(z0_)); f32x16 zero16; _Pragma("unroll") for(int r=0;r<16;++r)zero16[r]=z0_;
  { f32x16 g=zero16; const char*kmb=shm+LDS_KMI+hi*512+r32*16;
    #pragma unroll
    for(int d0=0;d0<4;++d0){const bf16x8 a=*reinterpret_cast<const bf16x8*>(kmb+d0*1024); g=__builtin_amdgcn_mfma_f32_32x32x16_bf16(a,qr[d0],g,0,0,0);}
    float g1=-INFINITY,g2=-INFINITY,g3=-INFINITY;
    #pragma unroll
    for(int r=0;r<16;++r){const int j=crow(r,hi); float v=__uint_as_float((__float_as_uint(g[r])&~31u)|(unsigned)(31-j)); v=(j<qb)?v:-INFINITY;
      g3=__builtin_amdgcn_fmed3f(g2,g3,v); g2=__builtin_amdgcn_fmed3f(g1,g2,v); g1=__builtin_fmaxf(g1,v);}
    float t1=-INFINITY,t2=-INFINITY,t3=-INFINITY;
    #define INS3(v) do{const float v_=(v); t3=__builtin_amdgcn_fmed3f(t2,t3,v_); t2=__builtin_amdgcn_fmed3f(t1,t2,v_); t1=__builtin_fmaxf(t1,v_);}while(0)
    {auto rr=__builtin_amdgcn_permlane32_swap(__float_as_uint(g1),__float_as_uint(g1),false,false);INS3(__uint_as_float(rr[0]));INS3(__uint_as_float(rr[1]));}
    {auto rr=__builtin_amdgcn_permlane32_swap(__float_as_uint(g2),__float_as_uint(g2),false,false);INS3(__uint_as_float(rr[0]));INS3(__uint_as_float(rr[1]));}
    {auto rr=__builtin_amdgcn_permlane32_swap(__float_as_uint(g3),__float_as_uint(g3),false,false);INS3(__uint_as_float(rr[0]));INS3(__uint_as_float(rr[1]));}
    #undef INS3
    if(t1>-INFINITY)mask|=1u<<(31u-(__float_as_uint(t1)&31u));
    if(t2>-INFINITY)mask|=1u<<(31u-(__float_as_uint(t2)&31u));
    if(t3>-INFINITY)mask|=1u<<(31u-(__float_as_uint(t3)&31u)); }
  float nm=-sl*(float)q0,l_reg=0.f;f32x16 o[2];o[0]=zero16;o[1]=zero16;f32x16 negm=zero16;asm volatile("":"+v"(negm));
  SETNEG(0);
  qkt(pA0,pA1,Kbase,qr,negm,r32,hi);asm volatile("s_nop 15\n\ts_nop 7":"+v"(pA0),"+v"(pA1));CMASK(pA0,pA1,0);
  { const float rm=rowmax(pA0,pA1); const float dl=__builtin_fmaxf(rm,0.f); nm-=dl;
    _Pragma("unroll") for(int r=0;r<16;++r){pA0[r]-=dl;pA1[r]-=dl;} }
  _Pragma("unroll") for(int r=0;r<16;++r)pA0[r]=__builtin_amdgcn_exp2f(pA0[r]);
  _Pragma("unroll") for(int r=0;r<16;++r)pA1[r]=__builtin_amdgcn_exp2f(pA1[r]);
  nm+=sl64;
  WAIT_BAR(0);
  DMA_K(3,0);DMA_V(1,SLOTB);
  ROT();
  kload8(kf,kp0+sl_cur);
  WAIT_BAR(2);
  s16x4 vlo[8],vhi[8]; u32x4 pw0,pw1,pw2,pw3;
  #define PKW(P,B) cvtpk_s(P[B],P[B+1])
  #define PAF(k) __builtin_bit_cast(bf16x8,pw##k)
  #define VFR(i) (bf16x8){vlo[i][0],vlo[i][1],vlo[i][2],vlo[i][3],vhi[i][0],vhi[i][1],vhi[i][2],vhi[i][3]}
  #define PIN(x) asm volatile("":"+v"(x))
  #define MX3(a,b,c) __builtin_fmaxf(__builtin_fmaxf((a),(b)),(c))
  #define QS(P,b) __builtin_fmaf(P[4*(b)+3],W43,__builtin_fmaf(P[4*(b)+2],W42,__builtin_fmaf(P[4*(b)+1],W41,P[4*(b)])))
  #define GAPA(MF,F0,W0,W1,PW) do{ MF; F0; PIN(sacc); W0; W1; PIN(PW); SBAR(); }while(0)
  #define EX(v) __builtin_amdgcn_exp2f(v)
  #define GAPB(MF,X,B) do{ MF; X[B]=EX(X[B]); X[B+1]=EX(X[B+1]); X[B+2]=EX(X[B+2]); X[B+3]=EX(X[B+3]); PIN(X); SBAR(); }while(0)
  #define VRD(i) do{ vlo[i]=vtr(vp_+(((i)>>2)*4096+((i)&3)*1024)); vhi[i]=vtr(vp_+(((i)>>2)*4096+((i)&3)*1024+512)); }while(0)
  #define KRD(G,j) do{ if(G){ kload2(kf,kp0+sl_next,j); SBAR(); } }while(0)
  #define STEP(C0,C1,P0,P1,t,GK,GV,GL) do{ SBAR(); \
    const lds_cptr vp_=vp0+sl_prev; \
    SETNEG(t); \
    VRD(0); SBAR(); float sacc; \
    GAPA(C0=__builtin_amdgcn_mfma_f32_32x32x16_bf16(kf[0],qr[0],negm,0,0,0), sacc=QS(P0,0),                                   pw0[0]=PKW(P0,0), pw0[1]=PKW(P0,2), pw0); \
    VRD(4); SBAR(); GAPA(C1=__builtin_amdgcn_mfma_f32_32x32x16_bf16(kf[1],qr[0],negm,0,0,0), sacc=__builtin_fmaf(QS(P0,1),W81,sacc),   pw0[2]=PKW(P0,4), pw0[3]=PKW(P0,6), pw0); \
    VRD(1); SBAR(); GAPA(C0=__builtin_amdgcn_mfma_f32_32x32x16_bf16(kf[2],qr[1],C0,0,0,0),   sacc=__builtin_fmaf(QS(P0,2),W82,sacc),   pw1[0]=PKW(P0,8), pw1[1]=PKW(P0,10), pw1); \
    VRD(5); SBAR(); GAPA(C1=__builtin_amdgcn_mfma_f32_32x32x16_bf16(kf[3],qr[1],C1,0,0,0),   sacc=__builtin_fmaf(QS(P0,3),W83,sacc)*rE32, pw1[2]=PKW(P0,12),pw1[3]=PKW(P0,14), pw1); \
    VRD(2); SBAR(); GAPA(C0=__builtin_amdgcn_mfma_f32_32x32x16_bf16(kf[4],qr[2],C0,0,0,0),   sacc+=QS(P1,0),                           pw2[0]=PKW(P1,0), pw2[1]=PKW(P1,2), pw2); \
    VRD(6); SBAR(); GAPA(C1=__builtin_amdgcn_mfma_f32_32x32x16_bf16(kf[5],qr[2],C1,0,0,0),   sacc=__builtin_fmaf(QS(P1,1),W81,sacc),   pw2[2]=PKW(P1,4), pw2[3]=PKW(P1,6), pw2); \
    VRD(3); SBAR(); GAPA(C0=__builtin_amdgcn_mfma_f32_32x32x16_bf16(kf[6],qr[3],C0,0,0,0),   sacc=__builtin_fmaf(QS(P1,2),W82,sacc),   pw3[0]=PKW(P1,8), pw3[1]=PKW(P1,10), pw3); \
    VRD(7); SBAR(); GAPA(C1=__builtin_amdgcn_mfma_f32_32x32x16_bf16(kf[7],qr[3],C1,0,0,0),   sacc=__builtin_fmaf(QS(P1,3),W83,sacc),   pw3[2]=PKW(P1,12),pw3[3]=PKW(P1,14), pw3); \
    l_reg=__builtin_fmaf(sacc,E32,l_reg); \
    if(GK){DMA_K((t)+3,sl_cur);} if(GV){DMA_V((t)+1,sl_next);} \
    CMASK(C0,C1,t); \
    { float a=MX3(C0[0],C0[1],C1[0]),b=MX3(C0[2],C0[3],C1[1]); a=MX3(a,C1[2],C1[3]); \
      _Pragma("unroll") for(int r=4;r<16;r+=4){a=MX3(a,C0[r],C0[r+1]);b=MX3(b,C0[r+2],C0[r+3]);a=MX3(a,C1[r],C1[r+1]);b=MX3(b,C1[r+2],C1[r+3]);} \
      float rm=__builtin_fmaxf(a,b); { auto rr=__builtin_amdgcn_permlane32_swap(__float_as_uint(rm),__float_as_uint(rm),false,false); rm=__builtin_fmaxf(__uint_as_float(rr[0]),__uint_as_float(rr[1])); } \
      resc=false; \
      if(__builtin_expect(__any(rm>(float)THRL),0)){ const float dl=__builtin_fmaxf(rm,0.f); nm-=dl; \
        _Pragma("unroll") for(int r=0;r<16;++r){C0[r]-=dl;C1[r]-=dl;} \
        const float f=__builtin_amdgcn_exp2f(-dl); l_reg*=f; if(hi==0)wsf[r32]=f; resc=true; } } \
    nm+=sl64; \
    SBAR(); \
    GAPB(o[0]=__builtin_amdgcn_mfma_f32_32x32x16_bf16(PAF(0),VFR(0),o[0],0,0,0), C0,0); \
    GAPB(o[1]=__builtin_amdgcn_mfma_f32_32x32x16_bf16(PAF(0),VFR(4),o[1],0,0,0), C0,4); \
    KRD(GL,0); GAPB(o[0]=__builtin_amdgcn_mfma_f32_32x32x16_bf16(PAF(1),VFR(1),o[0],0,0,0), C0,8); \
    KRD(GL,1); GAPB(o[1]=__builtin_amdgcn_mfma_f32_32x32x16_bf16(PAF(1),VFR(5),o[1],0,0,0), C0,12); \
    KRD(GL,2); GAPB(o[0]=__builtin_amdgcn_mfma_f32_32x32x16_bf16(PAF(2),VFR(2),o[0],0,0,0), C1,0); \
    KRD(GL,3); GAPB(o[1]=__builtin_amdgcn_mfma_f32_32x32x16_bf16(PAF(2),VFR(6),o[1],0,0,0), C1,4); \
    GAPB(o[0]=__builtin_amdgcn_mfma_f32_32x32x16_bf16(PAF(3),VFR(3),o[0],0,0,0), C1,8); \
    GAPB(o[1]=__builtin_amdgcn_mfma_f32_32x32x16_bf16(PAF(3),VFR(7),o[1],0,0,0), C1,12); \
    }while(0)
  int t=1;
  #undef CMASK
  #define CMASK(P0,P1,t) do{}while(0)
  for(;t+5<NT;t+=2){
    STEP(pB0,pB1,pA0,pA1,t,true,true,true);     WAIT_BAR(2); RESC(); ROT();
    STEP(pA0,pA1,pB0,pB1,t+1,true,true,true);   WAIT_BAR(2); RESC(); ROT();
  }
  #undef CMASK
  #define CMASK(P0,P1,t) do{int jb_=(t)-(NT-4); if(jb_>=0)cmask(P0,P1,jb_,qrel,hi);}while(0)
  #define ENDW(tt) do{ if((tt)+3<NT){WAIT_BAR(2);} else if((tt)+2<NT){WAIT_BAR(1);} else {WAIT_BAR(0);} }while(0)
  for(;t+1<NT;t+=2){
    STEP(pB0,pB1,pA0,pA1,t,(t+3<NT),(t+1<NT),(t+1<NT));       ENDW(t);   RESC(); ROT();
    STEP(pA0,pA1,pB0,pB1,t+1,(t+4<NT),(t+2<NT),(t+2<NT));     ENDW(t+1); RESC(); ROT();
  }
  STEP(pB0,pB1,pA0,pA1,NT-1,false,false,false); RESC();
  { const float sacc=__builtin_fmaf(QS(pB0,3),W83,__builtin_fmaf(QS(pB0,2),W82,__builtin_fmaf(QS(pB0,1),W81,QS(pB0,0)))), sacd=__builtin_fmaf(QS(pB1,3),W83,__builtin_fmaf(QS(pB1,2),W82,__builtin_fmaf(QS(pB1,1),W81,QS(pB1,0)))); l_reg+=sacc+sacd*E32;
    pw0=(u32x4){PKW(pB0,0),PKW(pB0,2),PKW(pB0,4),PKW(pB0,6)};pw1=(u32x4){PKW(pB0,8),PKW(pB0,10),PKW(pB0,12),PKW(pB0,14)};pw2=(u32x4){PKW(pB1,0),PKW(pB1,2),PKW(pB1,4),PKW(pB1,6)};pw3=(u32x4){PKW(pB1,8),PKW(pB1,10),PKW(pB1,12),PKW(pB1,14)};
    SBAR(); pv(o,vb0+sl_cur,PAF(0),PAF(1),PAF(2),PAF(3)); }
  #undef PKW
  #undef PAF
  #undef VFR
  #undef PIN
  #undef MX3
  #undef GAPA
  #undef QS
  #undef GAPB
  #undef EX
  #undef VRD
  #undef KRD
  #undef STEP
  #undef ENDW
  const int lane_e=mk_lane_id(),r32e=lane_e&31,hie=lane_e>>5;
  l_reg*=hie?E4:1.f;
  {auto rr=__builtin_amdgcn_permlane32_swap(__float_as_uint(l_reg),__float_as_uint(l_reg),false,false);l_reg=__uint_as_float(rr[0])+__uint_as_float(rr[1]);}
  if(hie==0)wsf[32+r32e]=l_reg;asm volatile("s_waitcnt lgkmcnt(0)":::"memory");
  float rli[16];
  #pragma unroll
  for(int r=0;r<16;++r)rli[r]=__builtin_amdgcn_rcpf(wsf[32+crow(r,hie)]);
  bf16*Ow=O+(rowbase+q0+wid*QBLK)*DM+h*D;
  { bf16*stg=(bf16*)(shm+LDS_OST)+wid*2048;
    #pragma unroll
    for(int r=0;r<16;++r){const int orow=crow(r,hie);
      #pragma unroll
      for(int d0=0;d0<2;++d0)stg[orow*64+d0*32+r32e]=__float2bfloat16(o[d0][r]*rli[r]);}
    asm volatile("s_waitcnt lgkmcnt(0)":::"memory");
    #pragma unroll
    for(int i=0;i<4;++i){const int row=i*8+(lane_e>>3),ch=lane_e&7; const u32x4 v=*(const u32x4*)(stg+row*64+ch*8); ATTN_STORE16(Ow+(long)row*DM+ch*8,v);} }
  asm volatile("s_waitcnt lgkmcnt(0)\n\ts_barrier":::"memory");
  #undef DMA_K
  #undef DMA_V
  #undef CMASK
  #undef SETNEG
  #undef UNI
  #undef RESC
  #undef ROT
}
constexpr int ATTN_LDS_BYTES=LDS_BYTES;
struct AttnTensors { const bf16* Q; const bf16* K; const bf16* V; bf16* O; };
struct AttnUnit { int bh; int qb; };
struct StaticOrder {
  int vcu;
  __device__ __forceinline__ explicit StaticOrder(int grid,int block):vcu((grid%8==0)?(block%8)*(grid/8)+block/8:block){}
  __device__ __forceinline__ bool next(int i,AttnUnit&u)const{ const int id=2*vcu+i; if(i>=2||id>=512)return false; const int s=vcu&15; u.bh=vcu>>4; u.qb=(i==0)?31-s:s; return true; }
  __device__ __forceinline__ void a_ready(const AttnUnit&)const{}
  __device__ __forceinline__ void done(const AttnUnit&)const{}
};
template<class Sched,int THRL=8> __device__ __forceinline__ void attn_phase(char*lds,const AttnTensors&T,const unsigned short*kmi,const Sched&S,const int wave_id){
  AttnUnit u;
  for(int i=0;S.next(i,u);++i){ S.a_ready(u); attn_unit<THRL>(u.bh/NHEAD,u.bh%NHEAD,u.qb,T.Q,T.K,T.V,T.O,kmi+(long)u.bh*2048,lds,wave_id); S.done(u); }
}
#undef SBAR
#undef WAIT_BAR
}

constexpr int NWAVES = 8;
constexpr int NB = 2, SEQ = 8192, D = 1024, M = NB * SEQ;
constexpr int NH = 8, HD = 64;
constexpr int MOBA_BLK = 256, NBLK = SEQ / MOBA_BLK;
constexpr int INC = 4608;
constexpr int ZC = 2560;
constexpr int ZQ = 0, ZK = 512, ZV = 1024, ZGU = 1536, ZGV = 2048;
constexpr int GC = 2048;
constexpr int PQC = 2048;
constexpr int NEXP = 16384;
constexpr float LN_EPS = 1e-5f;
constexpr float ALPHA = 1.189207115002721f;
constexpr float LOG2E = 1.4426950408889634f;
constexpr float C2 = 0.125f * LOG2E;
constexpr float USCALE = 64.0f, VSCALE = 4.0f;

constexpr size_t MiB = 1u << 20;
constexpr size_t WS_CTL = 0, CTL_ZERO_BYTES = 1 * MiB;
constexpr size_t WS_MOD = 1 * MiB;
constexpr size_t WS_KMEAN = 1 * MiB + 64 * 1024;
constexpr size_t WS_WIN = 2 * MiB;
constexpr size_t WS_WA = 11 * MiB, WS_WG = 12 * MiB;
constexpr size_t WS_WOUT = 13 * MiB;
constexpr size_t WS_WPQ = 15 * MiB;
constexpr size_t WS_U8 = 20 * MiB, WS_V8 = 36 * MiB;
constexpr size_t WS_XN = 84 * MiB;
constexpr size_t WS_ZC = 116 * MiB;
constexpr size_t WS_TS = 180 * MiB;
constexpr size_t WS_IDX = 196 * MiB, WS_GW = 204 * MiB;
constexpr size_t WS_END = 212 * MiB;
constexpr int CW_BAR = 4096;

constexpr int RING_BYTES = 131072;
constexpr int LDSCTL_OFF = RING_BYTES, MISC_OFF = LDSCTL_OFF + 320;
constexpr int LDS_BYTES = 147456;

struct Frame {
    LAS unsigned char* lds;
    volatile LAS unsigned* MISC;
    gu32* ctl;
    int wave, G;
    const float *x, *c, *w_cond, *b_cond, *w_in, *w_attn_up, *w_gmlp_up, *w_out, *sgu_ln_g, *sgu_ln_b, *w_spatial, *b_spatial, *ln1_g, *ln1_b, *w_peer_q, *sub_keys, *peer_u, *peer_v, *ln2_g, *ln2_b;
    float* out;
    float *mod, *ts, *gw; int* idx; bf16* kmi;
    bf16 *win_t, *wa_t, *wg_t, *wout_t, *wpq_t, *xn, *zc, *pq, *gates; unsigned char *u8, *v8;
};

__device__ __forceinline__ float wave_sum(float v) {
#pragma unroll
    for (int o = 1; o < 64; o <<= 1) v += __shfl_xor(v, o);
    return v;
}
__device__ __forceinline__ float bflo(unsigned w) { return __uint_as_float(w << 16); }
__device__ __forceinline__ float bfhi(unsigned w) { return __uint_as_float(w & 0xffff0000u); }
__device__ __forceinline__ float silu1(float x) { return x / (1.0f + __expf(-x)); }
__device__ __forceinline__ float gelu_erf(float x) { return 0.5f * x * (1.0f + erff(x * 0.70710678118654752f)); }

__device__ __forceinline__ void p0_transpose_item(const float* W, int K, int N, bf16* WT, LAS float* scr, int item, int lane) {
    const int nblk = N / 32, kb = item / nblk, nb = item % nblk, k0 = 64 * kb, n0 = 32 * nb;
#pragma unroll 8
    for (int i = 0; i < 32; ++i) { const int kk = 2 * i + (lane >> 5); scr[kk * 33 + (lane & 31)] = W[(size_t)(k0 + kk) * N + n0 + (lane & 31)]; }
    LDS_WAIT(); asm volatile("" ::: "memory");
    const int c = lane & 7;
#pragma unroll
    for (int j = 0; j < 4; ++j) { const int n = (lane >> 3) + 8 * j; const LAS float* s = scr + (8 * c) * 33 + n;
        v4u o; o.x = pk2(s[0 * 33], s[1 * 33]); o.y = pk2(s[2 * 33], s[3 * 33]); o.z = pk2(s[4 * 33], s[5 * 33]); o.w = pk2(s[6 * 33], s[7 * 33]);
        *(GAS v4u*)(WT + (size_t)(n0 + n) * K + k0 + 8 * c) = o; }
    LDS_WAIT(); asm volatile("" ::: "memory");
}

__device__ __forceinline__ void p0_prologue(Frame& F) {
    const int LANE = mk_lane_id(), TID = F.wave * 64 + LANE;
    {
        LAS float* part = (LAS float*)F.lds;
        for (int cg = blockIdx.x; cg < 256; cg += F.G) {
            if (TID < 384) {
                const int col = TID % 24, ks = TID / 24, j = 24 * cg + col;
                float a0 = 0.f, a1 = 0.f;
                for (int k = 64 * ks; k < 64 * ks + 64; ++k) {
                    const float wv = F.w_cond[(size_t)k * 6144 + j];
                    a0 += silu1(F.c[k]) * wv; a1 += silu1(F.c[1024 + k]) * wv;
                }
                part[(ks * 24 + col) * 2 + 0] = a0; part[(ks * 24 + col) * 2 + 1] = a1;
            }
            __syncthreads();
            if (TID < 48) {
                const int col = TID % 24, b = TID / 24; float s = F.b_cond[24 * cg + col];
                for (int ks = 0; ks < 16; ++ks) s += part[(ks * 24 + col) * 2 + b];
                F.mod[b * 6144 + 24 * cg + col] = s;
            }
            __syncthreads();
        }
    }
    {
        LAS float* scr = (LAS float*)(F.lds + F.wave * 16384);
        const int gw = blockIdx.x * NWAVES + F.wave, NGW = F.G * NWAVES;
        constexpr int I_IN = (D / 64) * (INC / 32), I_UP = (512 / 64) * (D / 32), I_OUT = (D / 64) * (D / 32), I_PQ = (D / 64) * (PQC / 32);
        constexpr int NITEMS = I_IN + 2 * I_UP + I_OUT + I_PQ;
        for (int it = gw; it < NITEMS; it += NGW) {
            int r = it;
            if (r < I_IN) { p0_transpose_item(F.w_in, D, INC, F.win_t, scr, r, LANE); continue; } r -= I_IN;
            if (r < I_UP) { p0_transpose_item(F.w_attn_up, 512, D, F.wa_t, scr, r, LANE); continue; } r -= I_UP;
            if (r < I_UP) { p0_transpose_item(F.w_gmlp_up, 512, D, F.wg_t, scr, r, LANE); continue; } r -= I_UP;
            if (r < I_OUT) { p0_transpose_item(F.w_out, D, D, F.wout_t, scr, r, LANE); continue; } r -= I_OUT;
            p0_transpose_item(F.w_peer_q, D, PQC, F.wpq_t, scr, r, LANE);
        }
    }
    {
        const size_t n16 = (size_t)NEXP * D / 16;
        const size_t gt = (size_t)blockIdx.x * (NWAVES * 64) + TID, NT = (size_t)F.G * (NWAVES * 64);
        for (size_t i = gt; i < 2 * n16; i += NT) {
            const bool second = i >= n16; const size_t j = second ? i - n16 : i; const float sc = second ? VSCALE : USCALE;
            const f32x4* sp = (const f32x4*)((second ? F.peer_v : F.peer_u) + j * 16);
            v4u o;
#pragma unroll
            for (int q = 0; q < 4; ++q) { const f32x4 a = sp[q] * sc; int w = __builtin_amdgcn_cvt_pk_fp8_f32(a.x, a.y, 0, false); w = __builtin_amdgcn_cvt_pk_fp8_f32(a.z, a.w, w, true); o[q] = (unsigned)w; }
            *(v4u*)((second ? F.v8 : F.u8) + j * 16) = o;
        }
    }
}

__device__ __forceinline__ void p1_modulate(Frame& F) {
    const int LANE = mk_lane_id(), TID = F.wave * 64 + LANE;
    const int gw = blockIdx.x * NWAVES + F.wave, NGW = F.G * NWAVES;
    for (int m = gw; m < M; m += NGW) {
        const int b = m >> 13;
        const f32x4* xr = (const f32x4*)(F.x + (size_t)m * D) + LANE;
        f32x4 v[4]; float s = 0.f;
#pragma unroll
        for (int j = 0; j < 4; ++j) { v[j] = xr[64 * j]; s += (v[j].x + v[j].y) + (v[j].z + v[j].w); }
        const float mean = wave_sum(s) * (1.f / D); float s2 = 0.f;
#pragma unroll
        for (int j = 0; j < 4; ++j) { v[j] = v[j] - mean; s2 += (v[j].x * v[j].x + v[j].y * v[j].y) + (v[j].z * v[j].z + v[j].w * v[j].w); }
        const float rstd = 1.f / sqrtf(wave_sum(s2) * (1.f / D) + LN_EPS);
        unsigned long long* o8 = (unsigned long long*)(F.xn + (size_t)m * D) + LANE;
#pragma unroll
        for (int j = 0; j < 4; ++j) {
            const int col = 4 * LANE + 256 * j;
            const f32x4 sh = *(const f32x4*)(F.mod + b * 6144 + col), sc = *(const f32x4*)(F.mod + b * 6144 + 1024 + col);
            const f32x4 y = v[j] * rstd * (sc + 1.0f) + sh;
            o8[64 * j] = (unsigned long long)pk2(y.x, y.y) | ((unsigned long long)pk2(y.z, y.w) << 32);
        }
    }
}

__device__ __forceinline__ void p3_kmean(Frame& F) {
    const int LANE = mk_lane_id(), TID = F.wave * 64 + LANE;
    const int gt = blockIdx.x * (NWAVES * 64) + TID, NT = F.G * (NWAVES * 64);
    for (int i = gt; i < NB * NBLK * 512; i += NT) {
        const int col = i & 511, bb = i >> 9, b = bb >> 5, blk = bb & 31, h = col >> 6, d = col & 63;
        const bf16* p = F.zc + (size_t)bb * 256 * ZC + ZK + col;
        float s = 0.f;
        for (int r = 0; r < 256; ++r) s += bflo((unsigned)p[(size_t)r * ZC]);
        F.kmi[(size_t)(b * 8 + h) * 2048 + (d >> 3) * 256 + blk * 8 + (d & 7)] = (bf16)f2bf(s * (1.0f / 256.0f));
    }
}

__device__ __forceinline__ void p3_sgu(Frame& F) {
    const int LANE = mk_lane_id(), TID = F.wave * 64 + LANE;
    LAS float* vvn = (LAS float*)F.lds;
    LAS float* wsp = (LAS float*)(F.lds + 32768);
    const int t = TID >> 2, dq = TID & 3;
    for (int u = blockIdx.x; u < 1024; u += F.G) {
        const int chunk = u >> 3, g = u & 7; const size_t row0 = (size_t)chunk * 128;
        __syncthreads();
        {
            const bf16* p = F.zc + (row0 + t) * ZC + ZGV + g * 64 + dq * 16;
            const v4u w0 = *(const v4u*)p, w1 = *(const v4u*)(p + 8);
            float v[16];
            v[0] = bflo(w0.x); v[1] = bfhi(w0.x); v[2] = bflo(w0.y); v[3] = bfhi(w0.y); v[4] = bflo(w0.z); v[5] = bfhi(w0.z); v[6] = bflo(w0.w); v[7] = bfhi(w0.w);
            v[8] = bflo(w1.x); v[9] = bfhi(w1.x); v[10] = bflo(w1.y); v[11] = bfhi(w1.y); v[12] = bflo(w1.z); v[13] = bfhi(w1.z); v[14] = bflo(w1.w); v[15] = bfhi(w1.w);
            float s = 0.f;
#pragma unroll
            for (int k = 0; k < 16; ++k) s += v[k];
            s += __shfl_xor(s, 1); s += __shfl_xor(s, 2);
            const float mean = s * (1.0f / 64.0f); float q = 0.f;
#pragma unroll
            for (int k = 0; k < 16; ++k) { v[k] -= mean; q += v[k] * v[k]; }
            q += __shfl_xor(q, 1); q += __shfl_xor(q, 2);
            const float rstd = 1.f / sqrtf(q * (1.0f / 64.0f) + LN_EPS);
#pragma unroll
            for (int k = 0; k < 16; ++k) { const int d = dq * 16 + k; vvn[t * 64 + d] = v[k] * rstd * F.sgu_ln_g[g * 64 + d] + F.sgu_ln_b[g * 64 + d]; }
        }
        for (int i = TID; i < 16384; i += NWAVES * 64) wsp[(i >> 7) * 129 + (i & 127)] = F.w_spatial[(size_t)g * 16384 + i];
        __syncthreads();
        float acc[16];
#pragma unroll
        for (int k = 0; k < 16; ++k) acc[k] = 0.f;
        for (int s = 0; s <= t; ++s) {
            const float wv = wsp[t * 129 + s];
            const LAS f32x4* vp = (const LAS f32x4*)(vvn + s * 64 + dq * 16);
#pragma unroll
            for (int k4 = 0; k4 < 4; ++k4) { const f32x4 x = vp[k4]; acc[4 * k4 + 0] += wv * x.x; acc[4 * k4 + 1] += wv * x.y; acc[4 * k4 + 2] += wv * x.z; acc[4 * k4 + 3] += wv * x.w; }
        }
        const float bsp = F.b_spatial[g * 128 + t];
        bf16* up = F.zc + (row0 + t) * ZC + ZGU + g * 64 + dq * 16;
        const v4u u0 = *(const v4u*)up, u1 = *(const v4u*)(up + 8);
        v4u o0, o1;
        o0.x = pk2(bflo(u0.x) * (acc[0] + bsp), bfhi(u0.x) * (acc[1] + bsp)); o0.y = pk2(bflo(u0.y) * (acc[2] + bsp), bfhi(u0.y) * (acc[3] + bsp));
        o0.z = pk2(bflo(u0.z) * (acc[4] + bsp), bfhi(u0.z) * (acc[5] + bsp)); o0.w = pk2(bflo(u0.w) * (acc[6] + bsp), bfhi(u0.w) * (acc[7] + bsp));
        o1.x = pk2(bflo(u1.x) * (acc[8] + bsp), bfhi(u1.x) * (acc[9] + bsp)); o1.y = pk2(bflo(u1.y) * (acc[10] + bsp), bfhi(u1.y) * (acc[11] + bsp));
        o1.z = pk2(bflo(u1.z) * (acc[12] + bsp), bfhi(u1.z) * (acc[13] + bsp)); o1.w = pk2(bflo(u1.w) * (acc[14] + bsp), bfhi(u1.w) * (acc[15] + bsp));
        *(v4u*)up = o0; *(v4u*)(up + 8) = o1;
    }
    __syncthreads();
}

__device__ __forceinline__ void p7_ln(Frame& F) {
    const int LANE = mk_lane_id(), TID = F.wave * 64 + LANE;
    const int gw = blockIdx.x * NWAVES + F.wave, NGW = F.G * NWAVES;
    for (int m = gw; m < M; m += NGW) {
        const int b = m >> 13;
        f32x4* xr = (f32x4*)(F.out + (size_t)m * D) + LANE;
        f32x4 v[4]; float s = 0.f;
#pragma unroll
        for (int j = 0; j < 4; ++j) { v[j] = xr[64 * j]; s += (v[j].x + v[j].y) + (v[j].z + v[j].w); }
        float mean = wave_sum(s) * (1.f / D); float s2 = 0.f;
#pragma unroll
        for (int j = 0; j < 4; ++j) { v[j] = v[j] - mean; s2 += (v[j].x * v[j].x + v[j].y * v[j].y) + (v[j].z * v[j].z + v[j].w * v[j].w); }
        float rstd = 1.f / sqrtf(wave_sum(s2) * (1.f / D) + LN_EPS);
        s = 0.f;
#pragma unroll
        for (int j = 0; j < 4; ++j) {
            const int col = 4 * LANE + 256 * j;
            v[j] = v[j] * rstd * *(const f32x4*)(F.ln1_g + col) + *(const f32x4*)(F.ln1_b + col);
            xr[64 * j] = v[j];
            s += (v[j].x + v[j].y) + (v[j].z + v[j].w);
        }
        mean = wave_sum(s) * (1.f / D); s2 = 0.f;
#pragma unroll
        for (int j = 0; j < 4; ++j) { v[j] = v[j] - mean; s2 += (v[j].x * v[j].x + v[j].y * v[j].y) + (v[j].z * v[j].z + v[j].w * v[j].w); }
        rstd = 1.f / sqrtf(wave_sum(s2) * (1.f / D) + LN_EPS);
        unsigned long long* o8 = (unsigned long long*)(F.xn + (size_t)m * D) + LANE;
#pragma unroll
        for (int j = 0; j < 4; ++j) {
            const int col = 4 * LANE + 256 * j;
            const f32x4 sh = *(const f32x4*)(F.mod + b * 6144 + 3072 + col), sc = *(const f32x4*)(F.mod + b * 6144 + 4096 + col);
            const f32x4 y = v[j] * rstd * (sc + 1.0f) + sh;
            o8[64 * j] = (unsigned long long)pk2(y.x, y.y) | ((unsigned long long)pk2(y.z, y.w) << 32);
        }
    }
}

__device__ __forceinline__ void ins16(float (&L)[16], float v) {
#pragma unroll
    for (int i = 15; i >= 1; --i) L[i] = __builtin_amdgcn_fmed3f(L[i - 1], L[i], v);
    L[0] = fmaxf(L[0], v);
}
typedef short mk_bf16x8 __attribute__((ext_vector_type(8)));
typedef float mk_f32x16 __attribute__((ext_vector_type(16)));
__device__ __forceinline__ int mk_crow(int r, int hi) { return (r & 3) + 8 * (r >> 2) + 4 * hi; }
__device__ __forceinline__ void p9_topk(Frame& F) {
    const int LANE = mk_lane_id(), TID = F.wave * 64 + LANE, r32 = LANE & 31, hi = LANE >> 5;
    LAS unsigned char* KL = F.lds;
    LAS int* SCR = (LAS int*)(F.lds + 65536) + F.wave * 2048;
    for (int u = blockIdx.x; u < 512; u += F.G) {
        const int h = u & 7, tb = u >> 3;
        __syncthreads();
#pragma unroll
        for (int i = 0; i < 8; ++i) {
            const int g = TID + 512 * i, c = g >> 11, n = (g >> 4) & 127, ch = g & 15;
            const f32x4* sp = (const f32x4*)(F.sub_keys + ((size_t)((h * 2 + c) * 128 + n)) * 128 + ch * 8);
            const f32x4 a = sp[0], b = sp[1];
            v4u o; o.x = pk2(a.x, a.y); o.y = pk2(a.z, a.w); o.z = pk2(b.x, b.y); o.w = pk2(b.z, b.w);
            *(LAS v4u*)(KL + c * 32768 + ch * 2048 + n * 16) = o;
        }
        __syncthreads();
        const int t = tb * 256 + F.wave * 32 + r32;
        float L0[16], L1[16];
#pragma unroll
        for (int c = 0; c < 2; ++c) {
            mk_f32x16 acc[4];
#pragma unroll
            for (int nb = 0; nb < 4; ++nb)
#pragma unroll
                for (int r = 0; r < 16; ++r) acc[nb][r] = 0.f;
            const bf16* qp = F.pq + (size_t)t * PQC + (h * 2 + c) * 128 + 8 * hi;
#pragma unroll
            for (int ks = 0; ks < 8; ++ks) {
                const mk_bf16x8 bq = *(const mk_bf16x8*)(qp + 16 * ks);
#pragma unroll
                for (int nb = 0; nb < 4; ++nb) {
                    const mk_bf16x8 ka = *(const LAS mk_bf16x8*)(KL + c * 32768 + (2 * ks + hi) * 2048 + (32 * nb + r32) * 16);
                    acc[nb] = __builtin_amdgcn_mfma_f32_32x32x16_bf16(ka, bq, acc[nb], 0, 0, 0);
                }
            }
            float L[16];
#pragma unroll
            for (int i = 0; i < 16; ++i) L[i] = -INFINITY;
#pragma unroll
            for (int nb = 0; nb < 4; ++nb)
#pragma unroll
                for (int r = 0; r < 16; ++r) ins16(L, __uint_as_float((__float_as_uint(acc[nb][r]) & ~127u) | (unsigned)(32 * nb + mk_crow(r, hi))));
            float P[16];
#pragma unroll
            for (int i = 0; i < 16; ++i) P[i] = __shfl_xor(L[i], 32);
#pragma unroll
            for (int i = 0; i < 16; ++i) ins16(L, P[i]);
#pragma unroll
            for (int i = 0; i < 16; ++i) { if (c == 0) L0[i] = L[i]; else L1[i] = L[i]; }
        }
#pragma unroll
        for (int k = 0; k < 16; ++k) { SCR[k * 64 + LANE] = (int)(__float_as_uint(L0[k]) & 127u); SCR[(16 + k) * 64 + LANE] = (int)(__float_as_uint(L1[k]) & 127u); }
#pragma unroll
        for (int k = 0; k < 16; ++k) { L0[k] = __uint_as_float(__float_as_uint(L0[k]) & ~127u); L1[k] = __uint_as_float(__float_as_uint(L1[k]) & ~127u); }
        float R[16];
#pragma unroll
        for (int k = 0; k < 16; ++k) R[k] = -INFINITY;
#pragma unroll
        for (int a = 0; a < 16; ++a)
#pragma unroll
            for (int b = 0; b < 16; ++b)
                if ((a + 1) * (b + 1) <= 16) ins16(R, __uint_as_float((__float_as_uint(L0[a] + L1[b]) & ~255u) | (unsigned)(a * 16 + b)));
        float e[16]; float sum = 0.f; const float r0 = __uint_as_float(__float_as_uint(R[0]) & ~255u);
#pragma unroll
        for (int k = 0; k < 16; ++k) { e[k] = __expf(__uint_as_float(__float_as_uint(R[k]) & ~255u) - r0); sum += e[k]; }
        const float inv = 1.0f / sum;
        asm volatile("s_waitcnt lgkmcnt(0)" ::: "memory");
#pragma unroll
        for (int k = 0; k < 16; ++k) {
            if ((k >> 3) == hi) {
                const unsigned bits = __float_as_uint(R[k]); const int a = (bits >> 4) & 15, b = bits & 15;
                const int i1 = SCR[a * 64 + LANE], i2 = SCR[(16 + b) * 64 + LANE];
                F.idx[(size_t)t * 128 + h * 16 + k] = i1 * 128 + i2;
                F.gw[(size_t)t * 128 + h * 16 + k] = e[k] * inv;
            }
        }
    }
    __syncthreads();
}

typedef float f32x2v __attribute__((ext_vector_type(2)));
__device__ __forceinline__ float dot16_fp8(const f32x2v (&h2)[8], v4u u) {
    f32x2v acc = {0.f, 0.f};
#pragma unroll
    for (int w = 0; w < 4; ++w) {
        const f32x2v lo = __builtin_amdgcn_cvt_pk_f32_fp8((int)u[w], false), hi = __builtin_amdgcn_cvt_pk_f32_fp8((int)u[w], true);
        acc = __builtin_elementwise_fma(lo, h2[2 * w], acc); acc = __builtin_elementwise_fma(hi, h2[2 * w + 1], acc);
    }
    return acc.x + acc.y;
}
__device__ __forceinline__ void p10_peer(Frame& F, const int reps) {
    const int LANE = mk_lane_id();
    const int gw = blockIdx.x * NWAVES + F.wave, NGW = F.G * NWAVES;
    const bool b0 = (LANE & 1) != 0, b1 = (LANE & 2) != 0, b2 = (LANE & 4) != 0;
    for (int m = gw; m < M; m += NGW) {
        const int b = m >> 13;
        f32x2v h2[8];
        {   const bf16* hp = F.xn + (size_t)m * D + LANE * 16;
            const v4u w0 = *(const v4u*)hp, w1 = *(const v4u*)(hp + 8);
            h2[0] = (f32x2v){bflo(w0.x), bfhi(w0.x)}; h2[1] = (f32x2v){bflo(w0.y), bfhi(w0.y)}; h2[2] = (f32x2v){bflo(w0.z), bfhi(w0.z)}; h2[3] = (f32x2v){bflo(w0.w), bfhi(w0.w)};
            h2[4] = (f32x2v){bflo(w1.x), bfhi(w1.x)}; h2[5] = (f32x2v){bflo(w1.y), bfhi(w1.y)}; h2[6] = (f32x2v){bflo(w1.z), bfhi(w1.z)}; h2[7] = (f32x2v){bflo(w1.w), bfhi(w1.w)}; }
        const int e0 = F.idx[(size_t)m * 128 + LANE], e1 = F.idx[(size_t)m * 128 + 64 + LANE];
        const float g0 = F.gw[(size_t)m * 128 + LANE], g1 = F.gw[(size_t)m * 128 + 64 + LANE];
        f32x2v acc[8];
        for (int rep_ = 0; rep_ < reps; ++rep_) {
        float aA = 0.f, aB = 0.f;
#pragma unroll 2
        for (int jb = 0; jb < 128; jb += 8) {
            v4u u[8];
#pragma unroll
            for (int k = 0; k < 8; ++k) { const int j = jb + k; const int e = __builtin_amdgcn_readlane(j < 64 ? e0 : e1, j & 63); u[k] = *(const v4u*)(F.u8 + (size_t)e * D + LANE * 16); }
            float d[8];
#pragma unroll
            for (int k = 0; k < 8; ++k) d[k] = dot16_fp8(h2, u[k]);
            float d4[4], d2[2];
#pragma unroll
            for (int i = 0; i < 4; ++i) { const float snd = b0 ? d[2 * i] : d[2 * i + 1], kp = b0 ? d[2 * i + 1] : d[2 * i]; d4[i] = kp + __shfl_xor(snd, 1); }
#pragma unroll
            for (int i = 0; i < 2; ++i) { const float snd = b1 ? d4[2 * i] : d4[2 * i + 1], kp = b1 ? d4[2 * i + 1] : d4[2 * i]; d2[i] = kp + __shfl_xor(snd, 2); }
            float d1; { const float snd = b2 ? d2[0] : d2[1], kp = b2 ? d2[1] : d2[0]; d1 = kp + __shfl_xor(snd, 4); }
            d1 += __shfl_xor(d1, 8); d1 += __shfl_xor(d1, 16); d1 += __shfl_xor(d1, 32);
            const bool mine = (LANE >> 3) == ((jb >> 3) & 7);
            if (jb < 64) aA = mine ? d1 : aA; else aB = mine ? d1 : aB;
        }
        const float wA = g0 * gelu_erf(aA * (1.0f / USCALE)), wB = g1 * gelu_erf(aB * (1.0f / USCALE));
#pragma unroll
        for (int k = 0; k < 8; ++k) acc[k] = (f32x2v){0.f, 0.f};
#pragma unroll 2
        for (int jb = 0; jb < 128; jb += 8) {
            v4u v[8];
#pragma unroll
            for (int k = 0; k < 8; ++k) { const int j = jb + k; const int e = __builtin_amdgcn_readlane(j < 64 ? e0 : e1, j & 63); v[k] = *(const v4u*)(F.v8 + (size_t)e * D + LANE * 16); }
#pragma unroll
            for (int k = 0; k < 8; ++k) { const int j = jb + k;
                const float w = __builtin_bit_cast(float, __builtin_amdgcn_readlane(__builtin_bit_cast(int, j < 64 ? wA : wB), j & 63));
                const f32x2v w2 = (f32x2v){w, w};
#pragma unroll
                for (int q = 0; q < 4; ++q) {
                    const f32x2v lo = __builtin_amdgcn_cvt_pk_f32_fp8((int)v[k][q], false), hi = __builtin_amdgcn_cvt_pk_f32_fp8((int)v[k][q], true);
                    acc[2 * q] = __builtin_elementwise_fma(lo, w2, acc[2 * q]); acc[2 * q + 1] = __builtin_elementwise_fma(hi, w2, acc[2 * q + 1]);
                } }
        }
        }
        float* xr = F.out + (size_t)m * D + LANE * 16; const float* gt = F.mod + b * 6144 + 5120 + LANE * 16;
        f32x4 y[4]; float s = 0.f;
#pragma unroll
        for (int q = 0; q < 4; ++q) {
            const f32x4 xa = *(const f32x4*)(xr + 4 * q), ga = *(const f32x4*)(gt + 4 * q);
            const f32x4 p = (f32x4){acc[2 * q].x, acc[2 * q].y, acc[2 * q + 1].x, acc[2 * q + 1].y} * (1.0f / VSCALE);
            y[q] = xa * ALPHA + (ga + 1.0f) * p; s += (y[q].x + y[q].y) + (y[q].z + y[q].w);
        }
        const float mean = wave_sum(s) * (1.f / D); float s2 = 0.f;
#pragma unroll
        for (int q = 0; q < 4; ++q) { y[q] = y[q] - mean; s2 += (y[q].x * y[q].x + y[q].y * y[q].y) + (y[q].z * y[q].z + y[q].w * y[q].w); }
        const float rstd = 1.f / sqrtf(wave_sum(s2) * (1.f / D) + LN_EPS);
#pragma unroll
        for (int q = 0; q < 4; ++q) *(f32x4*)(xr + 4 * q) = y[q] * rstd * *(const f32x4*)(F.ln2_g + LANE * 16 + 4 * q) + *(const f32x4*)(F.ln2_b + LANE * 16 + 4 * q);
    }
}

struct FnZ {
    bf16* zc; bf16* gates;
    __device__ __forceinline__ void operator()(int row, int col, pg8::f32x4 v0, pg8::f32x4 v1, int pn) const {
        if (pn < 2) { v0 = v0 * C2; v1 = v1 * C2; }
        else if (pn == 4 || pn == 5) { const float f = __builtin_amdgcn_exp2f(__builtin_amdgcn_exp2f(-(float)(((col - ZV) >> 6) + 1)) * LOG2E * (float)(row & 63)); v0 = v0 * f; v1 = v1 * f; }
        else if (pn >= 6 && pn < 10) { v0 = pg8::gelu4(v0); v1 = pg8::gelu4(v1); }
        else if (pn >= 10) { v0 = pg8::sigm4(v0); v1 = pg8::sigm4(v1); }
        bf16* dst = (pn < 10) ? zc + (size_t)row * ZC + col : gates + (size_t)row * GC + (col - ZC);
        *(pg8::u32x4*)dst = pg8::pack8(v0, v1);
    }
};
struct FnUpA {
    bf16* zc; const bf16* gates;
    __device__ __forceinline__ void operator()(int row, int col, pg8::f32x4 v0, pg8::f32x4 v1, int) const {
        pg8::f32x4 g0, g1; pg8::unpack8(*(const pg8::u32x4*)(gates + (size_t)row * GC + col), g0, g1);
        *(pg8::u32x4*)(zc + (size_t)row * ZC + 512 + col) = pg8::pack8(v0 * g0, v1 * g1);
    }
};
struct FnUpB {
    bf16* zc; const bf16* gates;
    __device__ __forceinline__ void operator()(int row, int col, pg8::f32x4 v0, pg8::f32x4 v1, int) const {
        pg8::f32x4 g0, g1, m0, m1; pg8::unpack8(*(const pg8::u32x4*)(gates + (size_t)row * GC + 1024 + col), g0, g1);
        bf16* p = zc + (size_t)row * ZC + 512 + col; pg8::unpack8(*(const pg8::u32x4*)p, m0, m1);
        *(pg8::u32x4*)p = pg8::pack8(m0 + v0 * g0, m1 + v1 * g1);
    }
};
struct FnV1 {
    const float* x; const float* mod; float* out;
    __device__ __forceinline__ void operator()(int row, int col, pg8::f32x4 v0, pg8::f32x4 v1, int) const {
        const int b = row >> 13; const float* gt = mod + b * 6144 + 2048 + col;
        const pg8::f32x4 x0 = *(const pg8::f32x4*)(x + (size_t)row * D + col), x1 = *(const pg8::f32x4*)(x + (size_t)row * D + col + 4);
        const pg8::f32x4 t0 = *(const pg8::f32x4*)gt, t1 = *(const pg8::f32x4*)(gt + 4);
        *(pg8::f32x4*)(out + (size_t)row * D + col) = x0 * ALPHA + (t0 + 1.0f) * v0;
        *(pg8::f32x4*)(out + (size_t)row * D + col + 4) = x1 * ALPHA + (t1 + 1.0f) * v1;
    }
};
struct FnPlain {
    bf16* o; int ldc;
    __device__ __forceinline__ void operator()(int row, int col, pg8::f32x4 v0, pg8::f32x4 v1, int) const { *(pg8::u32x4*)(o + (size_t)row * ldc + col) = pg8::pack8(v0, v1); }
};

constexpr int NPH = 11;
#ifndef MK_PER_PHASE
#define MK_PER_PHASE 0
#endif
struct Args { const float* in[20]; float* out; unsigned char* ws; int ph_lo, ph_hi; };
__global__ void __launch_bounds__(NWAVES * 64, 2) mk_fwd(Args args) {
    extern __shared__ __attribute__((aligned(16))) unsigned char lds[];
    Frame F;
    F.lds = (LAS unsigned char*)lds;
    F.MISC = (volatile LAS unsigned*)(F.lds + MISC_OFF);
    F.wave = __builtin_amdgcn_readfirstlane((int)threadIdx.x >> 6); F.G = gridDim.x;
    unsigned char* ws = args.ws;
    F.ctl = (gu32*)(ws + WS_CTL);
    F.x = args.in[0]; F.c = args.in[1]; F.w_cond = args.in[2]; F.b_cond = args.in[3]; F.w_in = args.in[4]; F.w_attn_up = args.in[5]; F.w_gmlp_up = args.in[6]; F.w_out = args.in[7];
    F.sgu_ln_g = args.in[8]; F.sgu_ln_b = args.in[9]; F.w_spatial = args.in[10]; F.b_spatial = args.in[11]; F.ln1_g = args.in[12]; F.ln1_b = args.in[13]; F.w_peer_q = args.in[14];
    F.sub_keys = args.in[15]; F.peer_u = args.in[16]; F.peer_v = args.in[17]; F.ln2_g = args.in[18]; F.ln2_b = args.in[19];
    F.out = args.out;
    F.mod = (float*)(ws + WS_MOD); F.kmi = (bf16*)(ws + WS_KMEAN); F.ts = (float*)(ws + WS_TS); F.gw = (float*)(ws + WS_GW); F.idx = (int*)(ws + WS_IDX);
    F.win_t = (bf16*)(ws + WS_WIN); F.wa_t = (bf16*)(ws + WS_WA); F.wg_t = (bf16*)(ws + WS_WG); F.wout_t = (bf16*)(ws + WS_WOUT); F.wpq_t = (bf16*)(ws + WS_WPQ);
    F.u8 = ws + WS_U8; F.v8 = ws + WS_V8; F.xn = (bf16*)(ws + WS_XN); F.zc = (bf16*)(ws + WS_ZC); F.pq = (bf16*)(ws + WS_ZC); F.gates = (bf16*)args.out;
    for (int u = threadIdx.x; u < (LDS_BYTES - LDSCTL_OFF) / 4; u += NWAVES * 64) ((LAS unsigned*)(F.lds + LDSCTL_OFF))[u] = 0u;
    __syncthreads();
    const int lo = args.ph_lo, hi = args.ph_hi;
    XcdBarrier bar; bar.bar = (unsigned*)(F.ctl + CW_BAR); bar.x = 0; bar.st = nullptr; bar.wave = F.wave;
    if (hi - lo > 1) bar = xcd_barrier_post((unsigned*)(F.ctl + CW_BAR), F.MISC + 8, F.wave);
#define IN(k) (lo <= (k) && (k) < hi)
#if defined(MK_DUP)
#define REPS(k) (MK_DUP == (k) ? 2 : 1)
#define DUPLOOP(k) for (int rep_ = 0; rep_ < REPS(k); ++rep_)
#else
#define REPS(k) 1
#define DUPLOOP(k)
#endif
#define SEAM(k) do { if (IN(k) && IN((k) + 1)) xcd_barrier(bar); } while (0)

    DUPLOOP(0) if (IN(0)) { p0_prologue(F); SEAM(0); }
#if defined(MK_EXTRA_BAR)
    for (int i_ = 0; i_ < MK_EXTRA_BAR; ++i_) xcd_barrier(bar);
#endif
    DUPLOOP(1) if (IN(1)) { p1_modulate(F); SEAM(1); }
    DUPLOOP(2) if (IN(2)) {
        pg8::Gemm g{F.xn, F.win_t, M, INC, D, D, D}; pg8::StaticOrder S; S.init(M, INC, F.G, (int)blockIdx.x);
        pg8::EpiFn<FnZ> E{FnZ{F.zc, F.gates}};
        pg8::gemm_phase<pg8::EpiFn<FnZ>, pg8::StaticOrder, true, true>(F.lds, g, S, E, F.wave);
        SEAM(2);
    }
    if (IN(3)) { p3_kmean(F); p3_sgu(F); SEAM(3); }
    if (IN(4)) {
        const attn_body::AttnTensors AT{(const attn_body::bf16*)(F.zc + ZQ), (const attn_body::bf16*)(F.zc + ZK), (const attn_body::bf16*)(F.zc + ZV), (attn_body::bf16*)(F.zc + ZQ)};
        const attn_body::StaticOrder S((int)F.G, (int)blockIdx.x);
        attn_body::attn_phase<attn_body::StaticOrder>((char*)lds, AT, (const unsigned short*)F.kmi, S, F.wave);
        SEAM(4);
    }
    DUPLOOP(5) if (IN(5)) {
        { pg8::Gemm g{F.zc + ZQ, F.wa_t, M, D, 512, ZC, 512}; pg8::StaticOrder S; S.init(M, D, F.G, (int)blockIdx.x);
          pg8::EpiFn<FnUpA> E{FnUpA{F.zc, F.gates}};
          pg8::gemm_phase<pg8::EpiFn<FnUpA>, pg8::StaticOrder, true, true>(F.lds, g, S, E, F.wave); }
        VM_WAIT(); __syncthreads();
        { pg8::Gemm g{F.zc + ZGU, F.wg_t, M, D, 512, ZC, 512}; pg8::StaticOrder S; S.init(M, D, F.G, (int)blockIdx.x);
          pg8::EpiFn<FnUpB> E{FnUpB{F.zc, F.gates}};
          pg8::gemm_phase<pg8::EpiFn<FnUpB>, pg8::StaticOrder, true, true>(F.lds, g, S, E, F.wave); }
        SEAM(5);
    }
    DUPLOOP(6) if (IN(6)) {
        pg8::Gemm g{F.zc + 512, F.wout_t, M, D, D, ZC, D}; pg8::StaticOrder S; S.init(M, D, F.G, (int)blockIdx.x);
        pg8::EpiFn<FnV1> E{FnV1{F.x, F.mod, F.out}};
        pg8::gemm_phase<pg8::EpiFn<FnV1>, pg8::StaticOrder, true, true>(F.lds, g, S, E, F.wave);
        SEAM(6);
    }
    if (IN(7)) { p7_ln(F); SEAM(7); }
    DUPLOOP(8) if (IN(8)) {
        pg8::Gemm g{F.xn, F.wpq_t, M, PQC, D, D, D}; pg8::StaticOrder S; S.init(M, PQC, F.G, (int)blockIdx.x);
        pg8::EpiFn<FnPlain> E{FnPlain{F.pq, PQC}};
        pg8::gemm_phase<pg8::EpiFn<FnPlain>, pg8::StaticOrder, true, true>(F.lds, g, S, E, F.wave);
        SEAM(8);
    }
    DUPLOOP(9) if (IN(9)) { p9_topk(F); SEAM(9); }
    if (IN(10)) { p10_peer(F, REPS(10)); }
#undef IN
#undef SEAM
}

extern "C" void kernel_launch(void* const* d_in, const int* in_sizes, int n_in, void* d_out, int out_size, void* d_ws, size_t ws_size, hipStream_t stream) {
    static int grid = 0;
    if (grid == 0) {
        if (n_in != 20 || in_sizes[0] != M * D || out_size != M * D || ws_size < WS_END) { fprintf(stderr, "kernel_launch: unexpected shapes (n_in %d, in0 %d, out %d, ws %zu); nothing launched\n", n_in, n_in > 0 ? in_sizes[0] : -1, out_size, ws_size); grid = -1; return; }
        int dev = 0, cus = 0;
        if (hipGetDevice(&dev) != hipSuccess || hipDeviceGetAttribute(&cus, hipDeviceAttributeMultiprocessorCount, dev) != hipSuccess) { grid = -1; return; }
        if (hipFuncSetAttribute((const void*)mk_fwd, hipFuncAttributeMaxDynamicSharedMemorySize, LDS_BYTES) != hipSuccess) { fprintf(stderr, "kernel_launch: hipFuncSetAttribute failed\n"); grid = -1; return; }
        (void)hipGetLastError();
        grid = cus < 256 ? cus : 256;
    }
    if (grid < 0) return;
    if (hipMemsetAsync((char*)d_ws + WS_CTL, 0, CTL_ZERO_BYTES, stream) != hipSuccess) return;
    Args a{};
    for (int i = 0; i < 20; ++i) a.in[i] = (const float*)d_in[i];
    a.out = (float*)d_out; a.ws = (unsigned char*)d_ws;
#if MK_PER_PHASE
    for (int p = 0; p < NPH; ++p) { a.ph_lo = p; a.ph_hi = p + 1; hipLaunchKernelGGL(mk_fwd, dim3(grid), dim3(NWAVES * 64), LDS_BYTES, stream, a); }
#else
    a.ph_lo = 0; a.ph_hi = NPH; hipLaunchKernelGGL(mk_fwd, dim3(grid), dim3(NWAVES * 64), LDS_BYTES, stream, a);
#endif
}
```
